# Optimizing an MI355X kernel written in HIP

```python
import math
import jax, jax.numpy as jnp
from jax import lax
import numpy as np

D_MODEL = 1024
BATCH = 4
SEQ = 8192
DEPTH = 1

RET_HEADS = 4
RET_DK = 128
RET_DV = 128
RET_CHUNK = 128
ROPE_BASE = 10000.0
ATT_Q_HEADS = 8
ATT_KV_HEADS = 2
ATT_GROUP = ATT_Q_HEADS // ATT_KV_HEADS
ATT_HEAD_DIM = 64
WINDOW = 128
ATT_BLOCK = 128
NUM_BUCKETS = 32
MAX_DISTANCE = 128
N_EXPERTS = 32
TOP_K = 4
D_FF = D_MODEL
SWIGLU_ALPHA = 1.702
SWIGLU_LIMIT = 7.0
MOE_BLOCK = 128
PLE_DIM = 256
EPS = 1e-5

RET_WIDTH = RET_HEADS * RET_DV
ATT_WIDTH = ATT_Q_HEADS * ATT_HEAD_DIM
MIX_WIDTH = RET_WIDTH + ATT_WIDTH
IN_SIZES = (RET_HEADS * RET_DK, RET_HEADS * RET_DK, RET_HEADS * RET_DV, RET_WIDTH,
            ATT_Q_HEADS * ATT_HEAD_DIM, ATT_KV_HEADS * ATT_HEAD_DIM, ATT_KV_HEADS * ATT_HEAD_DIM)
IN_WIDTH = sum(IN_SIZES)

kernel_name = "hymba_retention_swa_sinks_moe_ple"


def rmsnorm(x, g):
    x32 = x.astype(jnp.float32)
    y = x32 * lax.rsqrt(jnp.mean(x32 * x32, axis=-1, keepdims=True) + EPS)
    return (y * g.astype(jnp.float32)).astype(x.dtype)


def split_cols(u, sizes):
    outs, start = [], 0
    for s in sizes:
        outs.append(u[..., start:start + s])
        start += s
    return outs


def rope(t, positions):
    half = t.shape[-1] // 2
    inv = ROPE_BASE ** (-jnp.arange(half, dtype=jnp.float32) / half)
    ang = positions.astype(jnp.float32)[..., None] * inv
    cos, sin = jnp.cos(ang)[:, :, None, :], jnp.sin(ang)[:, :, None, :]
    t32 = t.astype(jnp.float32)
    t1, t2 = t32[..., :half], t32[..., half:]
    return jnp.concatenate([t1 * cos - t2 * sin, t1 * sin + t2 * cos], axis=-1).astype(t.dtype)


def retention(q, k, v, positions):
    B, S, H, dk = q.shape
    dv = v.shape[-1]
    dt = q.dtype
    q = rope(q, positions)
    k = rope(k, positions) * (dk ** -0.5)
    C = RET_CHUNK
    nc = S // C
    qc = q.reshape(B, nc, C, H, dk)
    kc = k.reshape(B, nc, C, H, dk)
    vc = v.reshape(B, nc, C, H, dv)
    log_g = jnp.log(1.0 - 2.0 ** (-5.0 - jnp.arange(H, dtype=jnp.float32)))
    c = jnp.arange(C)
    diff = (c[:, None] - c[None, :]).astype(jnp.float32)
    dmask = jnp.where(diff >= 0, jnp.exp(jnp.maximum(diff, 0.0)[None] * log_g[:, None, None]), 0.0).astype(dt)
    scores = jnp.einsum('bnchd,bnmhd->bnhcm', qc, kc) * dmask
    inner = jnp.einsum('bnhcm,bnmhe->bnche', scores, vc)
    cf = c.astype(jnp.float32)
    k_decay = jnp.exp((C - 1 - cf)[None, :] * log_g[:, None]).astype(dt)
    q_decay = jnp.exp((cf + 1)[None, :] * log_g[:, None]).astype(dt)
    chunk_decay = jnp.exp(C * log_g).astype(dt)
    kv = jnp.einsum('bnmhd,bnmhe,hm->bnhde', kc, vc, k_decay)

    def step(state, kv_n):
        new = state * chunk_decay[None, :, None, None] + kv_n
        return new, state

    init = jnp.zeros((B, H, dk, dv), kv.dtype)
    _, r_prev = lax.scan(step, init, jnp.moveaxis(kv, 1, 0))
    r_prev = jnp.moveaxis(r_prev, 0, 1)
    cross = jnp.einsum('bnchd,bnhde,hc->bnche', qc, r_prev, q_decay)
    return (inner + cross).reshape(B, S, H, dv)


def t5_bucket(n):
    max_exact = NUM_BUCKETS // 2
    nf = jnp.maximum(n, 1).astype(jnp.float32)
    large = max_exact + (jnp.log(nf / max_exact) / math.log(MAX_DISTANCE / max_exact)
                         * (NUM_BUCKETS - max_exact)).astype(jnp.int32)
    large = jnp.minimum(large, NUM_BUCKETS - 1)
    return jnp.where(n < max_exact, n, large)


def sliding_window_attention(q, k, v, sinks, bias_table):
    B, S, Hq, dh = q.shape
    L = ATT_BLOCK
    nb = S // L
    qb = q.reshape(B, nb, L, ATT_KV_HEADS, ATT_GROUP, dh)

    def band(t):
        tp = jnp.concatenate([jnp.zeros_like(t[:, :L]), t], axis=1)
        tp = tp.reshape(B, nb + 1, L, ATT_KV_HEADS, dh)
        return jnp.concatenate([tp[:, :-1], tp[:, 1:]], axis=2)

    kb, vb = band(k), band(v)
    qi = jnp.arange(L)[:, None]
    ki = jnp.arange(2 * L)[None, :]
    dist = qi + L - ki
    band_ok = (dist >= 0) & (dist < WINDOW)
    key_ok = (jnp.arange(nb)[:, None] * L - L + ki) >= 0
    mask = band_ok[None] & key_ok[:, None, :]
    bucket = t5_bucket(jnp.maximum(dist, 0))
    bias = jnp.transpose(bias_table[bucket], (2, 0, 1)).astype(jnp.float32)
    bias = bias.reshape(ATT_KV_HEADS, ATT_GROUP, L, 2 * L)
    s = jnp.einsum('bnqhgd,bnkhd->bnhgqk', qb, kb).astype(jnp.float32) * (dh ** -0.5) + bias
    s = jnp.where(mask[None, :, None, None], s, jnp.finfo(jnp.float32).min)
    sink = jnp.broadcast_to(sinks.astype(jnp.float32).reshape(1, 1, ATT_KV_HEADS, ATT_GROUP, 1, 1),
                            s.shape[:-1] + (1,))
    probs = jax.nn.softmax(jnp.concatenate([s, sink], axis=-1), axis=-1)[..., :-1].astype(v.dtype)
    o = jnp.einsum('bnhgqk,bnkhd->bnqhgd', probs, vb)
    return o.reshape(B, S, Hq, dh)


def clamped_swiglu(h):
    glu = jnp.minimum(h[..., ::2], SWIGLU_LIMIT)
    lin = jnp.clip(h[..., 1::2], -SWIGLU_LIMIT, SWIGLU_LIMIT)
    return glu * jax.nn.sigmoid(SWIGLU_ALPHA * glu) * (lin + 1.0)


def moe(x, w_router, b_router, w_up, b_up, w_down, b_down):
    B, S, D = x.shape
    N = B * S
    xf = x.reshape(N, D)
    logits = (xf @ w_router + b_router).astype(jnp.float32)
    top_v, top_i = lax.top_k(logits, TOP_K)
    gate = jax.nn.softmax(top_v, axis=-1).astype(x.dtype)
    n_slots = N * TOP_K
    flat_e = top_i.reshape(-1)
    order = jnp.argsort(flat_e, stable=True)
    sorted_e = flat_e[order]
    counts = jnp.bincount(flat_e, length=N_EXPERTS)
    padded = (counts + MOE_BLOCK - 1) // MOE_BLOCK * MOE_BLOCK
    off = jnp.cumsum(counts) - counts
    pend = jnp.cumsum(padded)
    poff = pend - padded
    dest_sorted = poff[sorted_e] + (jnp.arange(n_slots) - off[sorted_e])
    cap = n_slots + N_EXPERTS * MOE_BLOCK
    n_blocks = cap // MOE_BLOCK
    row_token = jnp.full((cap,), N, jnp.int32).at[dest_sorted].set((order // TOP_K).astype(jnp.int32))
    block_e = jnp.minimum(jnp.searchsorted(pend, jnp.arange(n_blocks) * MOE_BLOCK, side='right'),
                          N_EXPERTS - 1)
    x_pad = jnp.concatenate([xf, jnp.zeros((1, D), xf.dtype)], axis=0)
    xb = x_pad[row_token].reshape(n_blocks, MOE_BLOCK, D)

    def expert_block(args):
        xblk, e = args
        h = xblk @ w_up[e] + b_up[e]
        return clamped_swiglu(h) @ w_down[e] + b_down[e]

    yb = lax.map(expert_block, (xb, block_e)).reshape(cap, D)
    slot_dest = jnp.zeros((n_slots,), dest_sorted.dtype).at[order].set(dest_sorted)
    y_slots = yb[slot_dest].reshape(N, TOP_K, D)
    return jnp.einsum('nk,nkd->nd', gate, y_slots).reshape(B, S, D)


def setup_inputs(seed: int = 0) -> dict:
    key = jax.random.key(seed)
    ks = jax.random.split(key, 24)

    def nrm(k, shape, scale):
        return jax.random.normal(k, shape, jnp.float32) * scale

    return {
        "x": nrm(ks[0], (BATCH, SEQ, D_MODEL), 1.0),
        "p": nrm(ks[1], (DEPTH, BATCH, SEQ, PLE_DIM), 1.0),
        "positions": (jnp.arange(SEQ, dtype=jnp.int32)[None, :]
                      + jax.random.randint(ks[2], (BATCH, 1), 0, 1024, jnp.int32)),
        "rel_bias_table": nrm(ks[3], (NUM_BUCKETS, ATT_Q_HEADS), 0.5),
        "g_mix_norm": 1.0 + nrm(ks[4], (DEPTH, D_MODEL), 0.01),
        "w_in": nrm(ks[5], (DEPTH, D_MODEL, IN_WIDTH), D_MODEL ** -0.5),
        "b_in": nrm(ks[6], (DEPTH, IN_WIDTH), 0.01),
        "ret_norm_g": 1.0 + nrm(ks[7], (DEPTH, RET_HEADS, RET_DV), 0.01),
        "att_sinks": nrm(ks[8], (DEPTH, ATT_Q_HEADS), 0.5),
        "w_out": nrm(ks[9], (DEPTH, MIX_WIDTH, D_MODEL), MIX_WIDTH ** -0.5),
        "g_moe_norm": 1.0 + nrm(ks[10], (DEPTH, D_MODEL), 0.01),
        "w_router": nrm(ks[11], (DEPTH, D_MODEL, N_EXPERTS), D_MODEL ** -0.5),
        "b_router": nrm(ks[12], (DEPTH, N_EXPERTS), 0.01),
        "w_up": nrm(ks[13], (DEPTH, N_EXPERTS, D_MODEL, 2 * D_FF), D_MODEL ** -0.5),
        "b_up": nrm(ks[14], (DEPTH, N_EXPERTS, 2 * D_FF), 0.01),
        "w_down": nrm(ks[15], (DEPTH, N_EXPERTS, D_FF, D_MODEL), D_FF ** -0.5),
        "b_down": nrm(ks[16], (DEPTH, N_EXPERTS, D_MODEL), 0.01),
        "w_ple_gate": nrm(ks[17], (DEPTH, D_MODEL, D_MODEL), D_MODEL ** -0.5),
        "w_ple_proj": nrm(ks[18], (DEPTH, PLE_DIM, D_MODEL), PLE_DIM ** -0.5),
        "g_ple_norm": 1.0 + nrm(ks[19], (DEPTH, D_MODEL), 0.01),
        "g_final": 1.0 + nrm(ks[20], (D_MODEL,), 0.01),
    }


def reference(x, p, positions, rel_bias_table, g_mix_norm, w_in, b_in, ret_norm_g, att_sinks,
              w_out, g_moe_norm, w_router, b_router, w_up, b_up, w_down, b_down,
              w_ple_gate, w_ple_proj, g_ple_norm, g_final):
    B, S, _ = x.shape
    h = x
    for i in range(DEPTH):
        hn = rmsnorm(h, g_mix_norm[i])
        u = hn @ w_in[i] + b_in[i]
        rq, rk, rv, rg, aq, ak, av = split_cols(u, IN_SIZES)
        ret = retention(rq.reshape(B, S, RET_HEADS, RET_DK), rk.reshape(B, S, RET_HEADS, RET_DK),
                        rv.reshape(B, S, RET_HEADS, RET_DV), positions)
        ret = rmsnorm(ret, ret_norm_g[i]).reshape(B, S, RET_WIDTH)
        ret = jax.nn.silu(rg) * ret
        att = sliding_window_attention(aq.reshape(B, S, ATT_Q_HEADS, ATT_HEAD_DIM),
                                       ak.reshape(B, S, ATT_KV_HEADS, ATT_HEAD_DIM),
                                       av.reshape(B, S, ATT_KV_HEADS, ATT_HEAD_DIM),
                                       att_sinks[i], rel_bias_table).reshape(B, S, ATT_WIDTH)
        h = h + jnp.concatenate([ret, att], axis=-1) @ w_out[i]
        h = h + moe(rmsnorm(h, g_moe_norm[i]), w_router[i], b_router[i],
                    w_up[i], b_up[i], w_down[i], b_down[i])
        gate = jax.nn.sigmoid(h @ w_ple_gate[i])
        h = h + rmsnorm(gate * (p[i] @ w_ple_proj[i]), g_ple_norm[i])
    return rmsnorm(h, g_final)
```

```cpp
#include <hip/hip_runtime.h>
#include <cstdio>
#include <cstdint>
#include <cmath>

#ifndef MK_N_LAUNCHES
#define MK_N_LAUNCHES 1
#endif

#define LAS __attribute__((address_space(3)))
#define GAS __attribute__((address_space(1)))
typedef unsigned short bf16;
typedef short bf16x8 __attribute__((ext_vector_type(8)));
typedef short s16x4 __attribute__((ext_vector_type(4)));
typedef float f32x4 __attribute__((ext_vector_type(4)));
typedef float f32x16 __attribute__((ext_vector_type(16)));
typedef float f32x2 __attribute__((ext_vector_type(2)));
typedef unsigned u32x4 __attribute__((ext_vector_type(4)));
typedef unsigned u32x2 __attribute__((ext_vector_type(2)));
typedef GAS unsigned gu32;

constexpr int NB = 4, SEQ = 8192, NTOK = NB * SEQ, DM = 1024, INW = 2816, PLE = 256;
constexpr int NEXP = 32, TOPK = 4, DFF = 1024, UPW = 2 * DFF;
constexpr int NCH = SEQ / 128;
constexpr int CAP_ROWS = NTOK * TOPK + NEXP * 256;
constexpr int MAX_TILES = CAP_ROWS / 256;
constexpr float EPS = 1e-5f;
constexpr int NWAVES = 8, NTHREADS = 512, GRID = 256;
constexpr float F8_WSCALE = 64.0f, F8_ASCALE = 8.0f;
constexpr int U_RQ = 0, U_RK = 512, U_RV = 1024, U_RG = 1536, U_AQ = 2048, U_AK = 2560, U_AV = 2688;

constexpr size_t MiB = 1u << 20;
constexpr size_t WS_CTL = 0, CTL_ZERO_BYTES = 32 * 1024;
constexpr size_t WS_WIN = 1 * MiB;
constexpr size_t WS_WOUT = 7 * MiB;
constexpr size_t WS_WG = 9 * MiB;
constexpr size_t WS_WP = 11 * MiB;
constexpr size_t WS_MISC = 12 * MiB;
constexpr size_t WS_ROPE = 16 * MiB;
constexpr size_t WS_WDN = 32 * MiB;
constexpr size_t WS_REGB = 96 * MiB;
constexpr size_t WS_WUP = WS_REGB;
constexpr size_t WS_XN = WS_WUP + 128 * MiB;
constexpr size_t WS_PB = WS_XN + 65 * MiB;
constexpr size_t WS_MIX = WS_PB + 16 * MiB;
constexpr size_t WS_Y = WS_REGB;
constexpr size_t WS_REGA = WS_MIX + 64 * MiB;
constexpr size_t WS_U = WS_REGA;
constexpr size_t WS_KVS = WS_U + 176 * MiB;
constexpr size_t WS_ST = WS_KVS + 64 * MiB;
constexpr size_t WS_ACT = WS_REGA;
constexpr size_t WS_H2B = WS_REGA;
constexpr size_t WS_PJ = WS_REGA + 272 * MiB;
constexpr size_t WS_H1B = WS_PJ + 64 * MiB;
constexpr size_t WS_H1F8 = WS_H1B + 65 * MiB;
constexpr size_t WS_END = WS_H1F8 + 33 * MiB;
static_assert(WS_Y + 256 * MiB <= WS_REGA, "Y overlays only region B");
static_assert(WS_END <= 1024 * MiB, "workspace");
constexpr size_t MS_BIN = 0;
constexpr size_t MS_TOPI = 64 * 1024;
constexpr size_t MS_GATE = MS_TOPI + 512 * 1024;
constexpr size_t MS_WGCNT = MS_GATE + 512 * 1024;
constexpr size_t MS_ROWTOK = MS_WGCNT + 64 * 1024;
constexpr size_t MS_ROWSLOT = MS_ROWTOK + 576 * 1024;
constexpr size_t MS_TILEE = MS_ROWSLOT + 576 * 1024;
constexpr size_t MS_META = MS_TILEE + 4096;
constexpr size_t MS_WRB = MS_META + 4096;
constexpr size_t MS_RSTD = MS_WRB + 128 * 1024;
constexpr size_t MS_ROWSCALE = MS_RSTD + 128 * 1024;
constexpr size_t MS_BUPP = MS_ROWSCALE + 576 * 1024;
static_assert(MS_BUPP + 256 * 1024 <= 4 * MiB, "misc");
constexpr size_t WS_RP = WS_KVS;
constexpr int CW_BAR = 4096;

constexpr int LDS_BYTES = 155648;
constexpr int MISC_OFF = 151 * 1024;
static_assert(131072 + 18 * 4 + 18 * 256 * 4 <= MISC_OFF, "MoE metadata fits under the control words");

#define LDS_WAIT() asm volatile("s_waitcnt lgkmcnt(0)" ::: "memory")
#define VM_WAIT() asm volatile("s_waitcnt vmcnt(0)" ::: "memory")

__device__ __forceinline__ unsigned f2bf(float f) { unsigned u = __builtin_bit_cast(unsigned, f); return (u + 0x7fffu + ((u >> 16) & 1u)) >> 16; }
__device__ __forceinline__ unsigned pk2(float lo, float hi) { return f2bf(lo) | (f2bf(hi) << 16); }
typedef __bf16 bf16x2_t __attribute__((ext_vector_type(2)));
__device__ __forceinline__ unsigned cvt_pk(float lo, float hi) { const f32x2 v = {lo, hi}; return __builtin_bit_cast(unsigned, __builtin_convertvector(v, bf16x2_t)); }
__device__ __forceinline__ unsigned pk4_fp8(float a, float b, float c, float d) { int w = 0; w = __builtin_amdgcn_cvt_pk_fp8_f32(a, b, w, false); w = __builtin_amdgcn_cvt_pk_fp8_f32(c, d, w, true); return (unsigned)w; }
__device__ __forceinline__ float bflo(unsigned w) { return __builtin_bit_cast(float, w << 16); }
__device__ __forceinline__ float bfhi(unsigned w) { return __builtin_bit_cast(float, w & 0xffff0000u); }
__device__ __forceinline__ float wave_sum(float v) {
#pragma unroll
    for (int o = 1; o < 64; o <<= 1) v += __shfl_xor(v, o);
    return v;
}
__device__ __forceinline__ float wave_max(float v) {
#pragma unroll
    for (int o = 1; o < 64; o <<= 1) v = fmaxf(v, __shfl_xor(v, o));
    return v;
}
__device__ __forceinline__ int wave_min_i(int v) {
#pragma unroll
    for (int o = 1; o < 64; o <<= 1) { const int t = __shfl_xor(v, o); v = t < v ? t : v; }
    return v;
}
__device__ __forceinline__ int opaque_tid() { int t = threadIdx.x; asm volatile("" : "+v"(t)); return t; }
__device__ __forceinline__ float sigmoidf_(float z) { return __builtin_amdgcn_rcpf(1.0f + __expf(-z)); }

#define XB_TMO      128
#define XB_XCNT(j)  (256  + 64 * (j))
#define XB_XSUB(j)  (1280 + 64 * (j))
#define XB_XGEN(j)  (2304 + 64 * (j))
#define XB_TOP      3328
#define XB_TOPGEN   3392
#define XCD_BAR_WORDS 3456
#define XB_SPIN_CAP (1u << 18)
__device__ __forceinline__ unsigned xb_ld(unsigned* p)              { return __hip_atomic_load(p, __ATOMIC_RELAXED, __HIP_MEMORY_SCOPE_AGENT); }
__device__ __forceinline__ unsigned xb_add(unsigned* p, unsigned v) { return __hip_atomic_fetch_add(p, v, __ATOMIC_RELAXED, __HIP_MEMORY_SCOPE_AGENT); }
__device__ __forceinline__ unsigned xb_xcc_id() { return (unsigned)__builtin_amdgcn_s_getreg((3 << 11) | 20) & 0xFu; }
#define XB_SPIN(cond, bar) do { unsigned _sp = 0; while (cond) { __builtin_amdgcn_s_sleep(1); \
    if ((++_sp & 255u) == 0u) { if (xb_ld(&(bar)[XB_TMO])) break; if (_sp > XB_SPIN_CAP) { atomicAdd(&(bar)[XB_TMO], 1u); break; } } } } while (0)
struct XcdBarrier { unsigned* bar; unsigned x; volatile LAS unsigned* st; };
__device__ __forceinline__ XcdBarrier xcd_barrier_post(unsigned* bar, volatile LAS unsigned* st) {
    XcdBarrier b; b.bar = bar; b.x = xb_xcc_id(); b.st = st;
    if (threadIdx.x == 0) (void)xb_add(&bar[XB_XCNT(b.x)], 1u);
    return b;
}
__device__ __forceinline__ void xcd_barrier_complete(unsigned* bar, unsigned x, unsigned& nloc, unsigned& nx) {
    const unsigned G = gridDim.x * gridDim.y * gridDim.z;
    unsigned sum, cnt, mine, sp = 0u;
    for (;;) {
        sum = 0u; cnt = 0u; mine = 0u;
#pragma unroll
        for (unsigned j = 0; j < 16; ++j) { const unsigned c = xb_ld(&bar[XB_XCNT(j)]); sum += c; cnt += (c > 0u) ? 1u : 0u; mine = (j == x) ? c : mine; }
        if (sum == G) break;
        __builtin_amdgcn_s_sleep(1);
        if ((++sp & 255u) == 0u) { if (xb_ld(&bar[XB_TMO])) break; if (sp > XB_SPIN_CAP) { atomicAdd(&bar[XB_TMO], 1u); break; } }
    }
    nloc = mine > 0u ? mine : 1u; nx = cnt > 0u ? cnt : 1u;
}
__device__ __forceinline__ void xcd_barrier(const XcdBarrier& b) {
    asm volatile("s_waitcnt vmcnt(0)" ::: "memory");
    __syncthreads();
    if (threadIdx.x == 0) {
        unsigned* bar = b.bar;
        __builtin_amdgcn_s_waitcnt(0);
        unsigned nloc = b.st[0], nx = b.st[1];
        if (nloc == 0u) { xcd_barrier_complete(bar, b.x, nloc, nx); b.st[0] = nloc; b.st[1] = nx; }
        const unsigned old = xb_add(&bar[XB_XSUB(b.x)], 1u);
        const unsigned gen = old / nloc;
        if (old + 1u == (gen + 1u) * nloc) {
            __builtin_amdgcn_fence(__ATOMIC_RELEASE, "agent");
            asm volatile("s_waitcnt vmcnt(0)" ::: "memory");
            const unsigned og = xb_add(&bar[XB_TOP], 1u);
            const unsigned tg = og / nx;
            if (og + 1u == (tg + 1u) * nx) xb_add(&bar[XB_TOPGEN], 1u);
            else XB_SPIN(xb_ld(&bar[XB_TOPGEN]) == tg, bar);
            __builtin_amdgcn_fence(__ATOMIC_ACQUIRE, "agent");
            xb_add(&bar[XB_XGEN(b.x)], 1u);
            asm volatile("s_waitcnt vmcnt(0)" ::: "memory");
        } else {
            XB_SPIN(xb_ld(&bar[XB_XGEN(b.x)]) == gen, bar);
            __builtin_amdgcn_fence(__ATOMIC_ACQUIRE, "agent");
            asm volatile("s_waitcnt vmcnt(0)" ::: "memory");
        }
    }
    __syncthreads();
}

namespace gx {
constexpr int BM = 256, BK = 64, HALF = 128, HTB = HALF * BK * 2, STAGE_BYTES = 8 * HTB, NXCD = 8, WGM = 8;
__device__ __forceinline__ int lds_byte(int r, int c) { const int st = (r >> 4) * 2 + (c >> 5), rr = r & 15, cc = c & 31, ob = rr * 64 + cc * 2; return st * 1024 + (ob ^ (((ob >> 9) & 1) << 5)); }
__device__ __forceinline__ void stage_rc(int b, int& R, int& C) { const int st = b / 1024, sb = b % 1024, swz = sb ^ (((sb >> 9) & 1) << 5); R = (st >> 1) * 16 + swz / 64; C = (st & 1) * 32 + (swz % 64) / 2; }
__device__ __forceinline__ void stage_rc_f8(int b, int& R, int& Cb) { const int st = b / 1024, sb = b % 1024, swz = sb ^ (((sb >> 9) & 1) << 5); R = (st >> 1) * 16 + swz / 64; Cb = 32 * ((swz % 64) / 16) + 16 * (st & 1) + (swz % 16); }
__device__ __forceinline__ int bcol(int h, int R) { return 16 * (4 * (R >> 5) + ((R >> 2) & 3)) + 8 * h + 4 * ((R >> 4) & 1) + (R & 3); }
struct Unit { int pm, pn, e; unsigned B; };
__device__ __forceinline__ bool tile_order(int i, int G, int c, int nM, int nN, int& pm, int& pn) {
    const int nwg = nM * nN; const long L = (long)i * G + c; if (L >= nwg) return false;
    int wgid = (int)L; { const int q = nwg / NXCD, r = nwg % NXCD, xcd = wgid % NXCD, off = wgid / NXCD; wgid = (xcd < r ? xcd * (q + 1) : r * (q + 1) + (xcd - r) * q) + off; }
    const int nig = WGM * nN, gid = wgid / nig, fm = gid * WGM, gsz = (nM - fm) < WGM ? (nM - fm) : WGM;
    pm = fm + ((wgid % nig) % gsz); pn = (wgid % nig) / gsz; return true;
}
struct SchedDense {
    int nM, nN, G, c, Kb; const char* Bt;
    __device__ __forceinline__ bool next(int i, Unit& u) const { if (!tile_order(i, G, c, nM, nN, u.pm, u.pn)) return false; u.e = 0; u.B = (unsigned)u.pn * 256u * (unsigned)Kb; return true; }
    __device__ __forceinline__ const char* wbase() const { return Bt; }
    __device__ __forceinline__ void finish(Unit& u, int, unsigned (&vo)[2][2], int tid) const {
#pragma unroll
        for (int i = 0; i < 2; ++i) { int R, C; stage_rc(tid * 16 + i * 8192, R, C);
#pragma unroll
            for (int h = 0; h < 2; ++h) vo[h][i] = (unsigned)((u.pm * 256 + h * 128 + R) * Kb + C * 2); }
    }
};
constexpr int MOE_MAX_UNITS = 18;
template <bool GATHER>
struct SchedMoe {
    int nM, nN, G, c, Kb; const char* W; size_t estride; const int* tile_e; const int* rowtok; LAS int* meta;
    __device__ __forceinline__ bool next(int i, Unit& u) const { return tile_order(i, G, c, nM, nN, u.pm, u.pn); }
    __device__ __forceinline__ const char* wbase() const { return W; }
    __device__ __forceinline__ void preload(int tid) const {
        for (int i = 0; i < MOE_MAX_UNITS; ++i) { Unit u; if (!next(i, u)) break;
            if (tid == 0) meta[i] = __hip_atomic_load(tile_e + u.pm, __ATOMIC_RELAXED, __HIP_MEMORY_SCOPE_AGENT);
            if (GATHER && tid < 256) meta[MOE_MAX_UNITS + i * 256 + tid] = rowtok[u.pm * 256 + tid]; }
        __syncthreads();
    }
    __device__ __forceinline__ void finish(Unit& u, int ord, unsigned (&vo)[2][2], int tid) const {
        u.e = __builtin_amdgcn_readfirstlane(meta[ord]); u.B = (unsigned)((size_t)u.e * estride) + (unsigned)u.pn * 256u * (unsigned)Kb;
#pragma unroll
        for (int i = 0; i < 2; ++i) { int R, Cb; stage_rc_f8(tid * 16 + i * 8192, R, Cb);
#pragma unroll
            for (int h = 0; h < 2; ++h) vo[h][i] = (unsigned)((GATHER ? meta[MOE_MAX_UNITS + ord * 256 + h * 128 + R] : (u.pm * 256 + h * 128 + R)) * Kb + Cb); }
    }
};
__device__ __forceinline__ void acc_zero(f32x16 (&acc)[2][2][2]) {
#pragma unroll
    for (int a = 0; a < 2; ++a)
#pragma unroll
        for (int b = 0; b < 2; ++b)
#pragma unroll
            for (int mh = 0; mh < 2; ++mh)
#pragma unroll
                for (int i = 0; i < 16; ++i) acc[a][b][mh][i] = 0.f;
}
__device__ __forceinline__ void acc_bias(f32x16 (&acc)[2][2][2], const float* b16, const float mul = 1.0f) {
    f32x4 t[4];
#pragma unroll
    for (int q = 0; q < 4; ++q) t[q] = *(const f32x4*)(b16 + 4 * q) * mul;
#pragma unroll
    for (int a = 0; a < 2; ++a)
#pragma unroll
        for (int b = 0; b < 2; ++b)
#pragma unroll
            for (int m = 0; m < 4; ++m)
#pragma unroll
                for (int n = 0; n < 2; ++n)
#pragma unroll
                    for (int i = 0; i < 4; ++i) acc[a][b][m >> 1][((m & 1) * 2 + n) * 4 + i] = t[2 * b + n][i];
}
typedef int v8i32 __attribute__((ext_vector_type(8)));
template <bool F8, class Epi, class Sched>
__device__ __forceinline__ void gemm(LAS unsigned char* lds, const char* A, const int Kb, const Sched& S, const Epi& E) {
    const int tid = opaque_tid(), wid = __builtin_amdgcn_readfirstlane(tid >> 6), lane = tid & 63, wr = wid >> 2, wc = wid & 3, fr = lane & 15, fq = lane >> 4;
    const int nt = Kb / 128;
    unsigned voB[2][2];
#pragma unroll
    for (int i = 0; i < 2; ++i) { int R, Cb; if (F8) stage_rc_f8(tid * 16 + i * 8192, R, Cb); else { int C; stage_rc(tid * 16 + i * 8192, R, C); Cb = C * 2; }
#pragma unroll
        for (int h = 0; h < 2; ++h) voB[h][i] = (unsigned)(Epi::bcolmap(h, R) * Kb + Cb); }
    const unsigned ldsw = (unsigned)wid * 1024u;
    const int aoff0 = lds_byte(wr * 64 + fr, fq * 8), aoff1 = aoff0 + 1024;
    const int boff0 = lds_byte(wc * 32 + fr, fq * 8), boff1 = boff0 + 1024;
#define GX_SA(b, h) (((b) * 2 + (h)) * HTB)
#define GX_SB(b, h) ((4 + (b) * 2 + (h)) * HTB)
#define GX_STAGE(bufoff, rsrc, soff, voff) do { _Pragma("unroll") for (int _i = 0; _i < 2; ++_i) \
        __builtin_amdgcn_raw_ptr_buffer_load_lds(rsrc, (LAS unsigned*)(lds + (bufoff) + ldsw + _i * 8192), 16, (int)(voff)[_i], (int)(soff), 0, 0); } while (0)
#define GX_LDA(dst, b, h) do { _Pragma("unroll") for (int m = 0; m < 4; ++m) { dst[m][0] = *(const LAS u32x4*)(lds + GX_SA(b, h) + aoff0 + m * 2048); dst[m][1] = *(const LAS u32x4*)(lds + GX_SA(b, h) + aoff1 + m * 2048); } } while (0)
#define GX_LDB(dst, b, h) do { _Pragma("unroll") for (int n = 0; n < 2; ++n) { dst[n][0] = *(const LAS u32x4*)(lds + GX_SB(b, h) + boff0 + n * 2048); dst[n][1] = *(const LAS u32x4*)(lds + GX_SB(b, h) + boff1 + n * 2048); } } while (0)
#define GX_MMA(ai, bj, At, Bt) do { __builtin_amdgcn_s_setprio(1); _Pragma("unroll") for (int m = 0; m < 4; ++m) _Pragma("unroll") for (int n = 0; n < 2; ++n) { \
        f32x16& _w = acc[ai][bj][m >> 1]; const int _o = ((m & 1) * 2 + n) * 4; f32x4 _c = {_w[_o], _w[_o + 1], _w[_o + 2], _w[_o + 3]}; \
        if constexpr (F8) { const v8i32 _b = {(int)Bt[n][0].x, (int)Bt[n][0].y, (int)Bt[n][0].z, (int)Bt[n][0].w, (int)Bt[n][1].x, (int)Bt[n][1].y, (int)Bt[n][1].z, (int)Bt[n][1].w}; \
            const v8i32 _a = {(int)At[m][0].x, (int)At[m][0].y, (int)At[m][0].z, (int)At[m][0].w, (int)At[m][1].x, (int)At[m][1].y, (int)At[m][1].z, (int)At[m][1].w}; \
            _c = __builtin_amdgcn_mfma_scale_f32_16x16x128_f8f6f4(_b, _a, _c, 0, 0, 0, 0x7f7f7f7f, 0, 0x7f7f7f7f); } \
        else { _Pragma("unroll") for (int k = 0; k < 2; ++k) _c = __builtin_amdgcn_mfma_f32_16x16x32_bf16(__builtin_bit_cast(bf16x8, Bt[n][k]), __builtin_bit_cast(bf16x8, At[m][k]), _c, 0, 0, 0); } \
        _w[_o] = _c[0]; _w[_o + 1] = _c[1]; _w[_o + 2] = _c[2]; _w[_o + 3] = _c[3]; } \
        __builtin_amdgcn_s_setprio(0); } while (0)
#define GX_WAIT_V(n) asm volatile("s_waitcnt vmcnt(" #n ")" ::: "memory")
#define GX_WAIT_L(n) asm volatile("s_waitcnt lgkmcnt(" #n ")" ::: "memory")
#define GX_BAR __builtin_amdgcn_s_barrier()
#define GX_SCHED __builtin_amdgcn_sched_barrier(0)
    Unit cur, nxt; int ui = 0;
    if (!S.next(0, cur)) return;
    u32x4 At[4][2], B0[2][2], B1[2][2];
    unsigned voC[2][2];
    S.finish(cur, 0, voC, tid);
    asm volatile("" : "+v"(voC[0][0]), "+v"(voC[0][1]), "+v"(voC[1][0]), "+v"(voC[1][1]));
    f32x16 acc[2][2][2];
    E.init(acc, cur, wc, fq);
    unsigned cB = cur.B;
    const __amdgpu_buffer_rsrc_t rA = __builtin_amdgcn_make_buffer_rsrc((void*)A, 0, -1, 0x00020000);
    const __amdgpu_buffer_rsrc_t rB = __builtin_amdgcn_make_buffer_rsrc((void*)S.wbase(), 0, -1, 0x00020000);
    GX_STAGE(GX_SB(0, 0), rB, cB, voB[0]); GX_STAGE(GX_SB(0, 1), rB, cB, voB[1]); GX_STAGE(GX_SA(0, 0), rA, 0, voC[0]); GX_STAGE(GX_SA(0, 1), rA, 0, voC[1]);
    if (wr == 1) GX_BAR;
    GX_WAIT_V(2); GX_BAR;
    GX_STAGE(GX_SB(1, 0), rB, cB + 128, voB[0]); GX_STAGE(GX_SA(1, 0), rA, 128, voC[0]); GX_STAGE(GX_SB(1, 1), rB, cB + 128, voB[1]);
    GX_WAIT_V(6); GX_BAR;
#define GX_KITER(a1, a2, b2, OA, O1) do { \
              \
            GX_LDB(B0, 0, 0); GX_LDB(B1, 0, 1); GX_SCHED; GX_LDA(At, 0, 0); GX_STAGE(GX_SA(1, 1), rA, a1, O1); \
            GX_WAIT_V(8); GX_WAIT_L(0); GX_BAR; GX_MMA(0, 0, At, B0); GX_MMA(0, 1, At, B1); GX_BAR; GX_SCHED; \
              \
            GX_LDA(At, 0, 1); GX_STAGE(GX_SB(0, 0), rB, b2, voB[0]); GX_STAGE(GX_SB(0, 1), rB, b2, voB[1]); GX_STAGE(GX_SA(0, 0), rA, a2, OA[0]); \
            GX_WAIT_V(8); GX_WAIT_L(0); GX_BAR; GX_MMA(1, 0, At, B0); GX_MMA(1, 1, At, B1); GX_BAR; GX_SCHED; \
              \
            GX_LDB(B0, 1, 0); GX_LDB(B1, 1, 1); GX_SCHED; GX_LDA(At, 1, 0); GX_STAGE(GX_SA(0, 1), rA, a2, OA[1]); \
            GX_WAIT_V(8); GX_WAIT_L(0); GX_BAR; GX_MMA(0, 0, At, B0); GX_MMA(0, 1, At, B1); GX_BAR; GX_SCHED; \
              \
            GX_LDA(At, 1, 1); GX_STAGE(GX_SB(1, 0), rB, (b2) + 128, voB[0]); GX_STAGE(GX_SB(1, 1), rB, (b2) + 128, voB[1]); GX_STAGE(GX_SA(1, 0), rA, (a2) + 128, OA[0]); \
            GX_WAIT_V(8); GX_WAIT_L(0); GX_BAR; GX_MMA(1, 0, At, B0); GX_MMA(1, 1, At, B1); GX_BAR; GX_SCHED; } while (0)
    for (;;) {
        const bool has_next = S.next(ui + 1, nxt);
        unsigned nB = cB;
#pragma unroll 1
        for (int t = 0; t < nt; t += 2) {
            const bool last = (t == nt - 2);
            unsigned o1[2] = {voC[1][0], voC[1][1]};
            if (last && has_next) {
                asm volatile("" ::: "memory");
                S.finish(nxt, ui + 1, voC, tid); nB = nxt.B;
                asm volatile("" : "+v"(voC[0][0]), "+v"(voC[0][1]), "+v"(voC[1][0]), "+v"(voC[1][1]));
            }
            const unsigned a1 = (unsigned)(t + 1) * 128u;
            const unsigned a2 = last ? 0u : (unsigned)(t + 2) * 128u;
            const unsigned b2 = last ? nB : cB + (unsigned)(t + 2) * 128u;
            GX_KITER(a1, a2, b2, voC, o1);
        }
        if (wr == 0) GX_BAR;
        E(acc, cur, wr, wc, fr, fq);
        if (!has_next) break;
        E.init(acc, nxt, wc, fq);
        cur = nxt; cB = nB; ++ui;
        if (wr == 1) GX_BAR;
    }
    GX_WAIT_V(0);
    GX_BAR;
#undef GX_KITER
#undef GX_SA
#undef GX_SB
#undef GX_STAGE
#undef GX_LDA
#undef GX_LDB
#undef GX_MMA
#undef GX_WAIT_V
#undef GX_WAIT_L
#undef GX_BAR
#undef GX_SCHED
}

#define GX_V16(v, ai, m) float v[16]; _Pragma("unroll") for (int bj = 0; bj < 2; ++bj) _Pragma("unroll") for (int n = 0; n < 2; ++n) _Pragma("unroll") for (int i = 0; i < 4; ++i) v[8 * bj + 4 * n + i] = acc[ai][bj][(m) >> 1][(((m) & 1) * 2 + n) * 4 + i];
__device__ __forceinline__ void store16_bf16(bf16* dst, const float (&v)[16]) {
    u32x4 w0, w1;
    w0.x = cvt_pk(v[0], v[1]); w0.y = cvt_pk(v[2], v[3]); w0.z = cvt_pk(v[4], v[5]); w0.w = cvt_pk(v[6], v[7]);
    w1.x = cvt_pk(v[8], v[9]); w1.y = cvt_pk(v[10], v[11]); w1.z = cvt_pk(v[12], v[13]); w1.w = cvt_pk(v[14], v[15]);
    *(u32x4*)dst = w0; *(u32x4*)(dst + 8) = w1;
}
struct EpiU {
    bf16* U; const float* bias; const float* rope;
    static __device__ __forceinline__ int bcolmap(int h, int R) { return bcol(h, R); }
    __device__ __forceinline__ void init(f32x16 (&acc)[2][2][2], const Unit& u, int wc, int fq) const { acc_bias(acc, bias + u.pn * 256 + 16 * (4 * wc + fq)); }
    __device__ __forceinline__ void operator()(const f32x16 (&acc)[2][2][2], const Unit& u, int wr, int wc, int fr, int fq) const {
        asm volatile("" : "+v"(fr), "+v"(fq));
        const int c16 = 16 * (4 * wc + fq), col0 = u.pn * 256 + c16;
        const bool do_rope = u.pn < 4; const float sc = (u.pn >= 2) ? 0.08838834764831845f : 1.0f;
        const int j0 = (col0 & 127) >> 1, row00 = u.pm * 256 + wr * 64 + fr;
        f32x4 nx[4];
        if (do_rope) { const f32x4* cs = (const f32x4*)(rope + ((size_t)row00 * 64 + j0) * 2);
#pragma unroll
            for (int q = 0; q < 4; ++q) nx[q] = cs[q]; }
#pragma unroll
        for (int gi = 0; gi < 8; ++gi) {
            const int ai = gi >> 2, m = gi & 3, row = row00 + ai * 128 + m * 16;
            GX_V16(v, ai, m)
            if (do_rope) {
                f32x4 cx[4];
#pragma unroll
                for (int q = 0; q < 4; ++q) cx[q] = nx[q];
                if (gi < 7) { const int rown = row00 + ((gi + 1) >> 2) * 128 + ((gi + 1) & 3) * 16; const f32x4* cs = (const f32x4*)(rope + ((size_t)rown * 64 + j0) * 2);
#pragma unroll
                    for (int q = 0; q < 4; ++q) nx[q] = cs[q]; }
#pragma unroll
                for (int q = 0; q < 4; ++q) { const f32x4 t = cx[q];
                    const float a0 = v[4 * q], a1 = v[4 * q + 1], b0 = v[4 * q + 2], b1 = v[4 * q + 3];
                    v[4 * q] = (a0 * t[0] - a1 * t[1]) * sc; v[4 * q + 1] = (a0 * t[1] + a1 * t[0]) * sc;
                    v[4 * q + 2] = (b0 * t[2] - b1 * t[3]) * sc; v[4 * q + 3] = (b0 * t[3] + b1 * t[2]) * sc; }
            }
            store16_bf16(U + (size_t)row * INW + col0, v);
            asm volatile("" ::: "memory");
        }
    }
};
struct EpiBf16Plain {
    bf16* O; int ldc;
    static __device__ __forceinline__ int bcolmap(int h, int R) { return bcol(h, R); }
    __device__ __forceinline__ void init(f32x16 (&acc)[2][2][2], const Unit&, int, int) const { acc_zero(acc); }
    __device__ __forceinline__ void operator()(const f32x16 (&acc)[2][2][2], const Unit& u, int wr, int wc, int fr, int fq) const {
        asm volatile("" : "+v"(fr), "+v"(fq));
        const int col0 = u.pn * 256 + 16 * (4 * wc + fq);
#pragma unroll
        for (int ai = 0; ai < 2; ++ai)
#pragma unroll
            for (int m = 0; m < 4; ++m) { const int row = u.pm * 256 + ai * 128 + wr * 64 + m * 16 + fr; GX_V16(v, ai, m) store16_bf16(O + (size_t)row * ldc + col0, v); asm volatile("" ::: "memory"); }
    }
};
struct EpiRouter {
    const float* x; bf16* H1B; unsigned char* H1F8; const bf16* WRB; float* RP;
    static __device__ __forceinline__ int bcolmap(int h, int R) { return bcol(h, R); }
    __device__ __forceinline__ void init(f32x16 (&acc)[2][2][2], const Unit&, int, int) const { acc_zero(acc); }
    __device__ __forceinline__ void operator()(const f32x16 (&acc)[2][2][2], const Unit& u, int wr, int wc, int fr, int fq) const {
        asm volatile("" : "+v"(fr), "+v"(fq));
        const int col0 = u.pn * 256 + 16 * (4 * wc + fq), row00 = u.pm * 256 + wr * 64;
        const bf16* wb = WRB + fr * 1024 + col0;
        const size_t qbase = (size_t)(u.pn * 4 + wc) * NTOK;
        bf16x8 bh[2][2], bl[2][2];
#pragma unroll
        for (int et = 0; et < 2; ++et)
#pragma unroll
            for (int s2 = 0; s2 < 2; ++s2) { bh[et][s2] = *(const bf16x8*)(wb + et * 16 * 1024 + 8 * s2); bl[et][s2] = *(const bf16x8*)(wb + 32 * 1024 + et * 16 * 1024 + 8 * s2); }
        f32x4 nx[4];
        { const float* xp = x + (size_t)(row00 + fr) * DM + col0;
#pragma unroll
          for (int q = 0; q < 4; ++q) nx[q] = *(const f32x4*)(xp + 4 * q); }
#pragma unroll
        for (int gi = 0; gi < 8; ++gi) {
            const int ai = gi >> 2, m = gi & 3, rowb = row00 + ai * 128 + m * 16, row = rowb + fr;
            const size_t off = (size_t)row * DM + col0; GX_V16(v, ai, m)
            f32x4 cx[4];
#pragma unroll
            for (int q = 0; q < 4; ++q) cx[q] = nx[q];
            if (gi < 7) { const float* xp = x + (size_t)(row00 + ((gi + 1) >> 2) * 128 + ((gi + 1) & 3) * 16 + fr) * DM + col0;
#pragma unroll
                for (int q = 0; q < 4; ++q) nx[q] = *(const f32x4*)(xp + 4 * q); }
#pragma unroll
            for (int q = 0; q < 4; ++q) { v[4 * q] += cx[q][0]; v[4 * q + 1] += cx[q][1]; v[4 * q + 2] += cx[q][2]; v[4 * q + 3] += cx[q][3]; }
            unsigned hp[8], lp[8]; float ss = 0.f;
#pragma unroll
            for (int q = 0; q < 8; ++q) { hp[q] = cvt_pk(v[2 * q], v[2 * q + 1]); lp[q] = cvt_pk(v[2 * q] - bflo(hp[q]), v[2 * q + 1] - bfhi(hp[q])); ss += v[2 * q] * v[2 * q] + v[2 * q + 1] * v[2 * q + 1]; }
            *(u32x4*)(H1B + off) = (u32x4){hp[0], hp[1], hp[2], hp[3]}; *(u32x4*)(H1B + off + 8) = (u32x4){hp[4], hp[5], hp[6], hp[7]};
            { u32x4 w8; w8.x = pk4_fp8(v[0] * F8_ASCALE, v[1] * F8_ASCALE, v[2] * F8_ASCALE, v[3] * F8_ASCALE); w8.y = pk4_fp8(v[4] * F8_ASCALE, v[5] * F8_ASCALE, v[6] * F8_ASCALE, v[7] * F8_ASCALE);
              w8.z = pk4_fp8(v[8] * F8_ASCALE, v[9] * F8_ASCALE, v[10] * F8_ASCALE, v[11] * F8_ASCALE); w8.w = pk4_fp8(v[12] * F8_ASCALE, v[13] * F8_ASCALE, v[14] * F8_ASCALE, v[15] * F8_ASCALE);
              *(u32x4*)(H1F8 + off) = w8; }
            ss += __shfl_xor(ss, 16); ss += __shfl_xor(ss, 32);
            const bf16x8 ah0 = __builtin_bit_cast(bf16x8, (u32x4){hp[0], hp[1], hp[2], hp[3]}), ah1 = __builtin_bit_cast(bf16x8, (u32x4){hp[4], hp[5], hp[6], hp[7]});
            const bf16x8 al0 = __builtin_bit_cast(bf16x8, (u32x4){lp[0], lp[1], lp[2], lp[3]}), al1 = __builtin_bit_cast(bf16x8, (u32x4){lp[4], lp[5], lp[6], lp[7]});
            float* rp = RP + (qbase + rowb + 4 * fq) * 36 + fr;
#pragma unroll
            for (int et = 0; et < 2; ++et) {
                f32x4 d = (f32x4){0.f, 0.f, 0.f, 0.f};
                d = __builtin_amdgcn_mfma_f32_16x16x32_bf16(ah0, bh[et][0], d, 0, 0, 0); d = __builtin_amdgcn_mfma_f32_16x16x32_bf16(ah1, bh[et][1], d, 0, 0, 0);
                d = __builtin_amdgcn_mfma_f32_16x16x32_bf16(al0, bh[et][0], d, 0, 0, 0); d = __builtin_amdgcn_mfma_f32_16x16x32_bf16(al1, bh[et][1], d, 0, 0, 0);
                d = __builtin_amdgcn_mfma_f32_16x16x32_bf16(ah0, bl[et][0], d, 0, 0, 0); d = __builtin_amdgcn_mfma_f32_16x16x32_bf16(ah1, bl[et][1], d, 0, 0, 0);
#pragma unroll
                for (int r = 0; r < 4; ++r) rp[r * 36 + 16 * et] = d[r];
            }
            if (fq == 0) RP[(qbase + row) * 36 + 32] = ss;
            asm volatile("" ::: "memory");
        }
    }
};
__device__ __forceinline__ int bcol_up(int h, int R) { const int L = 4 * (R >> 5) + ((R >> 2) & 3), n = (R >> 4) & 1, i = R & 3; return 16 * L + 2 * (2 * (2 * h + n) + (i & 1)) + (i >> 1); }
struct EpiUp {
    unsigned char* ACT; const float* bupp; const float* rowscale;
    static __device__ __forceinline__ int bcolmap(int h, int R) { return bcol_up(h, R); }
    __device__ __forceinline__ void init(f32x16 (&acc)[2][2][2], const Unit&, int, int) const { acc_zero(acc); }
    __device__ __forceinline__ void prefetch(const Unit&, int, int) const {}
    __device__ __forceinline__ void operator()(const f32x16 (&acc)[2][2][2], const Unit& u, int wr, int wc, int fr, int fq) const {
        asm volatile("" : "+v"(fr), "+v"(fq));
        const int c16 = 16 * (4 * wc + fq), col0 = u.pn * 256 + c16;
        f32x4 bq[4];
#pragma unroll
        for (int q = 0; q < 4; ++q) bq[q] = *(const f32x4*)(bupp + (size_t)u.e * UPW + col0 + 4 * q);
        float rsv[8];
#pragma unroll
        for (int gi = 0; gi < 8; ++gi) rsv[gi] = rowscale[u.pm * 256 + (gi >> 2) * 128 + wr * 64 + (gi & 3) * 16 + fr];
#pragma unroll
        for (int ai = 0; ai < 2; ++ai)
#pragma unroll
            for (int m = 0; m < 4; ++m) { const int row = u.pm * 256 + ai * 128 + wr * 64 + m * 16 + fr; const float rs = rsv[ai * 4 + m];
                f32x2 o[4];
#pragma unroll
                for (int q = 0; q < 4; ++q) { const int bj = q >> 1, n = q & 1; const f32x16& w16 = acc[ai][bj][m >> 1]; const int ob = ((m & 1) * 2 + n) * 4;
                    f32x2 G = {w16[ob], w16[ob + 1]}, Lv = {w16[ob + 2], w16[ob + 3]};
                    G = G * rs + (f32x2){bq[q][0], bq[q][1]}; Lv = Lv * rs + (f32x2){bq[q][2], bq[q][3]};
                    G[0] = fminf(G[0], 7.0f); G[1] = fminf(G[1], 7.0f); Lv[0] = fminf(fmaxf(Lv[0], -7.0f), 7.0f); Lv[1] = fminf(fmaxf(Lv[1], -7.0f), 7.0f);
                    const f32x2 z = G * (-1.702f * 1.4426950408889634f);
                    f32x2 d = {__builtin_amdgcn_exp2f(z[0]), __builtin_amdgcn_exp2f(z[1])}; d = d + 1.0f;
                    const f32x2 sg = {__builtin_amdgcn_rcpf(d[0]), __builtin_amdgcn_rcpf(d[1])};
                    o[q] = (G * sg) * (Lv * F8_ASCALE + F8_ASCALE); }
                u32x2 w; w.x = pk4_fp8(o[0][0], o[0][1], o[1][0], o[1][1]); w.y = pk4_fp8(o[2][0], o[2][1], o[3][0], o[3][1]);
                *(u32x2*)(ACT + (size_t)row * DFF + (col0 >> 1)) = w; asm volatile("" ::: "memory"); }
    }
};
constexpr float F8_YSCALE = 16.0f;
struct EpiDown {
    unsigned char* Y; const float* b_dn; const int* rowslot;
    static __device__ __forceinline__ int bcolmap(int h, int R) { return bcol(h, R); }
    __device__ __forceinline__ void init(f32x16 (&acc)[2][2][2], const Unit&, int, int) const { acc_zero(acc); }
    __device__ __forceinline__ void operator()(const f32x16 (&acc)[2][2][2], const Unit& u, int wr, int wc, int fr, int fq) const {
        asm volatile("" : "+v"(fr), "+v"(fq));
        const int col0 = u.pn * 256 + 16 * (4 * wc + fq);
        float bv[16];
#pragma unroll
        for (int q = 0; q < 4; ++q) { const f32x4 t = *(const f32x4*)(b_dn + (size_t)u.e * DM + col0 + 4 * q); bv[4 * q] = t[0]; bv[4 * q + 1] = t[1]; bv[4 * q + 2] = t[2]; bv[4 * q + 3] = t[3]; }
        int slv[8];
#pragma unroll
        for (int gi = 0; gi < 8; ++gi) slv[gi] = rowslot[u.pm * 256 + (gi >> 2) * 128 + wr * 64 + (gi & 3) * 16 + fr];
#pragma unroll
        for (int ai = 0; ai < 2; ++ai)
#pragma unroll
            for (int m = 0; m < 4; ++m) { const int slot = slv[ai * 4 + m]; GX_V16(v, ai, m)
#pragma unroll
                for (int i = 0; i < 16; ++i) v[i] = v[i] * (F8_YSCALE / (F8_WSCALE * F8_ASCALE)) + bv[i] * F8_YSCALE;
                if (slot >= 0) { u32x4 w8; w8.x = pk4_fp8(v[0], v[1], v[2], v[3]); w8.y = pk4_fp8(v[4], v[5], v[6], v[7]); w8.z = pk4_fp8(v[8], v[9], v[10], v[11]); w8.w = pk4_fp8(v[12], v[13], v[14], v[15]);
                    *(u32x4*)(Y + (size_t)slot * DM + col0) = w8; }
                asm volatile("" ::: "memory"); }
    }
};
struct EpiGate {
    const bf16* PJ; bf16* T;
    static __device__ __forceinline__ int bcolmap(int h, int R) { return bcol(h, R); }
    __device__ __forceinline__ void init(f32x16 (&acc)[2][2][2], const Unit&, int, int) const { acc_zero(acc); }
    __device__ __forceinline__ void prefetch(const Unit&, int, int) const {}
    __device__ __forceinline__ void operator()(const f32x16 (&acc)[2][2][2], const Unit& u, int wr, int wc, int fr, int fq) const {
        asm volatile("" : "+v"(fr), "+v"(fq));
        const int col0 = u.pn * 256 + 16 * (4 * wc + fq), row00 = u.pm * 256 + wr * 64 + fr;
        u32x4 pq[4][2];
#pragma unroll
        for (int j = 0; j < 4; ++j) { const size_t o = (size_t)(row00 + j * 16) * DM + col0; pq[j][0] = *(const u32x4*)(PJ + o); pq[j][1] = *(const u32x4*)(PJ + o + 8); }
#pragma unroll
        for (int gi = 0; gi < 8; ++gi) {
            const int ai = gi >> 2, m = gi & 3; const size_t off = (size_t)(row00 + ai * 128 + m * 16) * DM + col0; GX_V16(v, ai, m)
            const u32x4 p0 = pq[gi & 3][0], p1 = pq[gi & 3][1];
            if (gi < 4) { const size_t offn = (size_t)(row00 + 128 + (gi & 3) * 16) * DM + col0; pq[gi & 3][0] = *(const u32x4*)(PJ + offn); pq[gi & 3][1] = *(const u32x4*)(PJ + offn + 8); }
            const unsigned pw[8] = {p0.x, p0.y, p0.z, p0.w, p1.x, p1.y, p1.z, p1.w};
#pragma unroll
            for (int q = 0; q < 8; ++q) { v[2 * q] = sigmoidf_(v[2 * q]) * bflo(pw[q]); v[2 * q + 1] = sigmoidf_(v[2 * q + 1]) * bfhi(pw[q]); }
            store16_bf16(T + off, v); asm volatile("" ::: "memory"); }
    }
};
}

struct Args {
    const float* x; const float* p; const int* positions; const float* rel_bias; const float* g_mix; const float* w_in; const float* b_in;
    const float* ret_g; const float* sinks; const float* w_out; const float* g_moe; const float* w_router; const float* b_router;
    const float* w_up; const float* b_up; const float* w_down; const float* b_down; const float* w_gate; const float* w_proj;
    const float* g_ple; const float* g_final;
    float* out; unsigned char* ws;
    float inv[64];
    unsigned char bucket[128];
    int ph_lo, ph_hi;
};

struct Frame {
    LAS unsigned char* lds; int tid, lane, wave, wg, G;
};

template <bool PERM, bool KSCALE>
__device__ __forceinline__ void p0_transpose_item(const float* W, int K, int N, bf16* WT, LAS float* scr, int item, int lane, const float* kscale) {
    const int nblk = N / 32, kb = item / nblk, nb = item % nblk, k0 = 64 * kb, n0 = 32 * nb;
    float wv[32];
#pragma unroll
    for (int i = 0; i < 32; ++i) { const int kk = 2 * i + (lane >> 5); wv[i] = __builtin_nontemporal_load(W + (size_t)(k0 + kk) * N + n0 + (lane & 31)); }
#pragma unroll
    for (int i = 0; i < 32; ++i) { const int kk = 2 * i + (lane >> 5); float w = wv[i]; if (KSCALE) w *= kscale[k0 + kk]; scr[kk * 33 + (lane & 31)] = w; }
    LDS_WAIT(); asm volatile("" ::: "memory");
    const int c = lane & 7;
#pragma unroll
    for (int j = 0; j < 4; ++j) { const int n = (lane >> 3) + 8 * j; const LAS float* s = scr + (8 * c) * 33 + n;
        u32x4 o; o.x = pk2(s[0 * 33], s[1 * 33]); o.y = pk2(s[2 * 33], s[3 * 33]); o.z = pk2(s[4 * 33], s[5 * 33]); o.w = pk2(s[6 * 33], s[7 * 33]);
        int dn = n0 + n;
        if (PERM && dn < 1024) { const int d = dn & 127; dn = (dn - d) + 2 * (d & 63) + (d >> 6); }
        *(GAS u32x4*)(WT + (size_t)dn * K + k0 + 8 * c) = o; }
    LDS_WAIT(); asm volatile("" ::: "memory");
}
template <bool KSCALE>
__device__ __forceinline__ void p0_transpose_item_f8(const float* W, int K, int N, unsigned char* WT, LAS float* scr, int item, int lane, const float* kscale) {
    const int nblk = N / 32, kb = item / nblk, nb = item % nblk, k0 = 64 * kb, n0 = 32 * nb;
    float wv[32];
#pragma unroll
    for (int i = 0; i < 32; ++i) { const int kk = 2 * i + (lane >> 5); wv[i] = __builtin_nontemporal_load(W + (size_t)(k0 + kk) * N + n0 + (lane & 31)); }
#pragma unroll
    for (int i = 0; i < 32; ++i) { const int kk = 2 * i + (lane >> 5); float w = wv[i] * F8_WSCALE; if (KSCALE) w *= kscale[k0 + kk]; scr[kk * 33 + (lane & 31)] = w; }
    LDS_WAIT(); asm volatile("" ::: "memory");
    const int n = lane >> 1, kh = (lane & 1) * 32; const LAS float* sp = scr + kh * 33 + n;
    u32x4 o0, o1;
    o0.x = pk4_fp8(sp[0 * 33], sp[1 * 33], sp[2 * 33], sp[3 * 33]); o0.y = pk4_fp8(sp[4 * 33], sp[5 * 33], sp[6 * 33], sp[7 * 33]); o0.z = pk4_fp8(sp[8 * 33], sp[9 * 33], sp[10 * 33], sp[11 * 33]); o0.w = pk4_fp8(sp[12 * 33], sp[13 * 33], sp[14 * 33], sp[15 * 33]);
    o1.x = pk4_fp8(sp[16 * 33], sp[17 * 33], sp[18 * 33], sp[19 * 33]); o1.y = pk4_fp8(sp[20 * 33], sp[21 * 33], sp[22 * 33], sp[23 * 33]); o1.z = pk4_fp8(sp[24 * 33], sp[25 * 33], sp[26 * 33], sp[27 * 33]); o1.w = pk4_fp8(sp[28 * 33], sp[29 * 33], sp[30 * 33], sp[31 * 33]);
    unsigned char* dst = WT + (size_t)(n0 + n) * K + k0 + kh;
    *(GAS u32x4*)dst = o0; *(GAS u32x4*)(dst + 16) = o1;
    LDS_WAIT(); asm volatile("" ::: "memory");
}
__device__ __forceinline__ void p0_prologue(const Args& a, const Frame& F) {
    unsigned char* ws = a.ws;
    LAS float* scr = (LAS float*)(F.lds + F.wave * 16384);
    const int gw = F.wg * NWAVES + F.wave, NGW = F.G * NWAVES;
    bf16* WIN = (bf16*)(ws + WS_WIN); bf16* WOUT = (bf16*)(ws + WS_WOUT); bf16* WG = (bf16*)(ws + WS_WG); bf16* WP = (bf16*)(ws + WS_WP);
    unsigned char* WUP = ws + WS_WUP; unsigned char* WDN = ws + WS_WDN;
    constexpr int I_IN = (DM / 64) * (INW / 32), I_SQ = (DM / 64) * (DM / 32), I_PJ = (PLE / 64) * (DM / 32);
    constexpr int I_UPE = (DM / 64) * (UPW / 32), I_DNE = (DFF / 64) * (DM / 32);
    constexpr int NITEMS = I_IN + 2 * I_SQ + I_PJ + NEXP * I_UPE + NEXP * I_DNE;
    for (int it = gw; it < NITEMS; it += NGW) {
        int r = it;
        if (r < I_IN) { p0_transpose_item<true, false>(a.w_in, DM, INW, WIN, scr, r, F.lane, nullptr); continue; } r -= I_IN;
        if (r < I_SQ) { p0_transpose_item<false, false>(a.w_out, DM, DM, WOUT, scr, r, F.lane, nullptr); continue; } r -= I_SQ;
        if (r < I_SQ) { p0_transpose_item<false, false>(a.w_gate, DM, DM, WG, scr, r, F.lane, nullptr); continue; } r -= I_SQ;
        if (r < I_PJ) { p0_transpose_item<false, false>(a.w_proj, PLE, DM, WP, scr, r, F.lane, nullptr); continue; } r -= I_PJ;
        if (r < NEXP * I_UPE) { const int e = r / I_UPE; p0_transpose_item_f8<true>(a.w_up + (size_t)e * DM * UPW, DM, UPW, WUP + (size_t)e * UPW * DM, scr, r % I_UPE, F.lane, a.g_moe); continue; } r -= NEXP * I_UPE;
        { const int e = r / I_DNE; p0_transpose_item_f8<false>(a.w_down + (size_t)e * DFF * DM, DFF, DM, WDN + (size_t)e * DM * DFF, scr, r % I_DNE, F.lane, nullptr); }
    }
    {
        bf16* XN = (bf16*)(ws + WS_XN);
        f32x4 g[4];
#pragma unroll
        for (int j = 0; j < 4; ++j) g[j] = ((const f32x4*)a.g_mix)[F.lane + 64 * j];
        for (int m0 = gw; m0 < NTOK; m0 += 4 * NGW) {
            f32x4 v[4][4];
#pragma unroll
            for (int rr = 0; rr < 4; ++rr) { const f32x4* xr = (const f32x4*)(a.x + (size_t)(m0 + rr * NGW) * DM) + F.lane;
#pragma unroll
                for (int j = 0; j < 4; ++j) v[rr][j] = __builtin_nontemporal_load(xr + 64 * j); }
#pragma unroll
            for (int rr = 0; rr < 4; ++rr) { float s = 0.f;
#pragma unroll
                for (int j = 0; j < 4; ++j) s += (v[rr][j][0] * v[rr][j][0] + v[rr][j][1] * v[rr][j][1]) + (v[rr][j][2] * v[rr][j][2] + v[rr][j][3] * v[rr][j][3]);
                const float rstd = 1.0f / sqrtf(wave_sum(s) * (1.0f / DM) + EPS);
                u32x2* o = (u32x2*)(XN + (size_t)(m0 + rr * NGW) * DM) + F.lane;
#pragma unroll
                for (int j = 0; j < 4; ++j) { u32x2 w; w.x = pk2(v[rr][j][0] * rstd * g[j][0], v[rr][j][1] * rstd * g[j][1]); w.y = pk2(v[rr][j][2] * rstd * g[j][2], v[rr][j][3] * rstd * g[j][3]); o[64 * j] = w; } }
        }
        if (F.wg == 0) { unsigned* z = (unsigned*)(ws + WS_H1F8 + (size_t)NTOK * DM); for (int i = F.tid; i < DM / 4; i += NTHREADS) z[i] = 0u; }
    }
    const int gt = F.wg * NTHREADS + F.tid, NGT = F.G * NTHREADS;
    {
        bf16* PB = (bf16*)(ws + WS_PB);
        for (int i0 = gt; i0 < NTOK * PLE / 8; i0 += 4 * NGT) {
            f32x4 v0[4], v1[4];
#pragma unroll
            for (int r = 0; r < 4; ++r) { v0[r] = __builtin_nontemporal_load((const f32x4*)a.p + 2 * (i0 + r * NGT)); v1[r] = __builtin_nontemporal_load((const f32x4*)a.p + 2 * (i0 + r * NGT) + 1); }
#pragma unroll
            for (int r = 0; r < 4; ++r) { u32x4 w; w.x = pk2(v0[r][0], v0[r][1]); w.y = pk2(v0[r][2], v0[r][3]); w.z = pk2(v1[r][0], v1[r][1]); w.w = pk2(v1[r][2], v1[r][3]); ((u32x4*)PB)[i0 + r * NGT] = w; } }
    }
    {
        f32x2* RT = (f32x2*)(ws + WS_ROPE);
        for (int i = gt; i < NTOK * 64; i += NGT) { const int row = i >> 6, j = i & 63;
            const float ang = (float)a.positions[row] * a.inv[j];
            double t = (double)ang * 0.15915494309189535; t -= rint(t);
            const float tf = (float)t;
            RT[i] = (f32x2){__builtin_amdgcn_cosf(tf), __builtin_amdgcn_sinf(tf)}; }
    }
    { bf16* WRB = (bf16*)(ws + WS_MISC + MS_WRB);
      for (int idx = gt; idx < DM * NEXP; idx += NGT) { const int k = idx >> 5, e = idx & 31; const float v = a.g_moe[k] * a.w_router[idx];
          const unsigned hi = f2bf(v); const float rem = v - __builtin_bit_cast(float, hi << 16); WRB[e * 1024 + k] = (bf16)hi; WRB[32 * 1024 + e * 1024 + k] = (bf16)f2bf(rem); } }
    { float* BP = (float*)(ws + WS_MISC + MS_BUPP);
      for (int c = gt; c < NEXP * UPW; c += NGT) { const int grp = c & ~15, k = c & 15, quad = k >> 2, i = k & 3, p = 2 * quad + (i & 1), kind = i >> 1; BP[c] = a.b_up[grp + 2 * p + kind]; } }
    { float* BP = (float*)(ws + WS_MISC + MS_BIN);
      for (int c = gt; c < INW; c += NGT) { int dn = c; if (c < 1024) { const int d = c & 127; dn = (c - d) + 2 * (d & 63) + (d >> 6); } BP[dn] = a.b_in[c]; } }
}

typedef short v4i16_t __attribute__((ext_vector_type(4)));
__device__ __forceinline__ s16x4 ds_tr(const LAS unsigned char* p) { return __builtin_bit_cast(s16x4, __builtin_amdgcn_ds_read_tr16_b64_v4i16((LAS v4i16_t*)p)); }
__device__ __forceinline__ bf16x8 tr_frag(const LAS unsigned char* T, int stride, int krowA, int krowB, int col0, int lane) {
    const int i = lane & 15, q = i >> 2, p = i & 3;
    const s16x4 lo = ds_tr(T + (krowA + q) * stride + (col0 + 4 * p) * 2), hi = ds_tr(T + (krowB + q) * stride + (col0 + 4 * p) * 2);
    return (bf16x8){lo[0], lo[1], lo[2], lo[3], hi[0], hi[1], hi[2], hi[3]};
}
__device__ __forceinline__ bf16x8 row_frag(const LAS unsigned char* T, int stride, int row, int col) { return *(const LAS bf16x8*)(T + row * stride + col * 2); }
__device__ __forceinline__ bf16x8 pack8(const f32x4& a, const f32x4& b) {
    u32x4 w; w.x = cvt_pk(a[0], a[1]); w.y = cvt_pk(a[2], a[3]); w.z = cvt_pk(b[0], b[1]); w.w = cvt_pk(b[2], b[3]);
    return __builtin_bit_cast(bf16x8, w);
}
#define MFMA16(a, b, c) __builtin_amdgcn_mfma_f32_16x16x32_bf16((a), (b), (c), 0, 0, 0)
constexpr int TS = 272;
constexpr int TILE_B = 128 * TS;

struct TileRegs { u32x4 v[4]; };
__device__ __forceinline__ void tile_load(TileRegs& r, const bf16* src, int pitch, int tid) {
#pragma unroll
    for (int i = 0; i < 4; ++i) { const int q = tid + NTHREADS * i, row = q >> 4, c = q & 15; r.v[i] = *(const u32x4*)(src + (size_t)row * pitch + c * 8); }
}
template <int SCALE>
__device__ __forceinline__ void tile_store(LAS unsigned char* T, const TileRegs& r, int tid, float lg) {
#pragma unroll
    for (int i = 0; i < 4; ++i) { const int q = tid + NTHREADS * i, row = q >> 4, c = q & 15;
        u32x4 v = r.v[i];
        if (SCALE) { const float s = __expf((float)(SCALE == 1 ? 127 - row : (SCALE == 2 ? row : -row)) * lg);
            v.x = cvt_pk(bflo(v.x) * s, bfhi(v.x) * s); v.y = cvt_pk(bflo(v.y) * s, bfhi(v.y) * s); v.z = cvt_pk(bflo(v.z) * s, bfhi(v.z) * s); v.w = cvt_pk(bflo(v.w) * s, bfhi(v.w) * s); }
        *(LAS u32x4*)(T + row * TS + c * 16) = v; }
}

__device__ __forceinline__ void ret_kv_phase(const Args& a, const Frame& F) {
    const bf16* U = (const bf16*)(a.ws + WS_U);
    bf16* KVS = (bf16*)(a.ws + WS_KVS);
    LAS unsigned char* Kt = F.lds; LAS unsigned char* Vt = F.lds + TILE_B;
    const int lane = F.lane, g = lane >> 4, i = lane & 15, e0 = 16 * F.wave;
    constexpr int NU = NB * NCH * 4;
    TileRegs rk, rv;
    int unit = F.wg;
    if (unit < NU) { const size_t t0 = (size_t)(unit >> 2) * 128; const int h = unit & 3; tile_load(rk, U + t0 * INW + U_RK + h * 128, INW, F.tid); tile_load(rv, U + t0 * INW + U_RV + h * 128, INW, F.tid); }
    for (; unit < NU; unit += F.G) {
        const int h = unit & 3;
        const float lg = __logf(1.0f - exp2f(-5.0f - (float)h));
        tile_store<0>(Kt, rk, F.tid, 0.f); tile_store<1>(Vt, rv, F.tid, lg);
        __syncthreads();
        const int nu = unit + F.G;
        if (nu < NU) { const size_t t0 = (size_t)(nu >> 2) * 128; const int hn = nu & 3; tile_load(rk, U + t0 * INW + U_RK + hn * 128, INW, F.tid); tile_load(rv, U + t0 * INW + U_RV + hn * 128, INW, F.tid); }
        f32x4 acc[8];
#pragma unroll
        for (int et = 0; et < 8; ++et) acc[et] = (f32x4){0.f, 0.f, 0.f, 0.f};
#pragma unroll
        for (int s = 0; s < 4; ++s) {
            const int kr = 32 * s + 8 * g;
            const bf16x8 af = tr_frag(Kt, TS, kr, kr + 4, e0, lane);
#pragma unroll
            for (int et = 0; et < 8; ++et) { const bf16x8 bfr = tr_frag(Vt, TS, kr, kr + 4, 16 * et, lane); acc[et] = MFMA16(af, bfr, acc[et]); }
        }
        bf16* dst = KVS + (size_t)unit * 16384 + e0 + 4 * g;
#pragma unroll
        for (int et = 0; et < 8; ++et) { u32x2 w; w.x = cvt_pk(acc[et][0], acc[et][1]); w.y = cvt_pk(acc[et][2], acc[et][3]); *(u32x2*)(dst + (16 * et + i) * 128) = w; }
        __syncthreads();
    }
}

constexpr int AS = 144;
__device__ __forceinline__ void swa_phase(const Args& a, const Frame& F) {
    const bf16* U = (const bf16*)(a.ws + WS_U);
    bf16* MIX = (bf16*)(a.ws + WS_MIX);
    LAS unsigned char* Ks = F.lds; LAS unsigned char* Vs = F.lds + 256 * AS; LAS float* tb = (LAS float*)(F.lds + 2 * 256 * AS);
    constexpr int NU = NB * NCH * 2;
    for (int t = F.tid; t < 8 * 128; t += NTHREADS) { const int hq = t >> 7, dist = t & 127; tb[t] = a.rel_bias[(int)a.bucket[dist] * 8 + hq]; }
    const int lane = F.lane, g = lane >> 4, i = lane & 15;
    u32x4 kreg[4], vreg[4];
#define SWA_LOAD(un) do { const int hk_ = (un) & 1, bn_ = (un) >> 1, nb_ = bn_ & (NCH - 1); const size_t t0_ = (size_t)bn_ * 128; \
        _Pragma("unroll") for (int it = 0; it < 4; ++it) { const int q = F.tid + NTHREADS * it, ki = q >> 3, c = q & 7; \
            kreg[it] = (u32x4){0u, 0u, 0u, 0u}; vreg[it] = kreg[it]; \
            if (nb_ > 0 || ki >= 128) { const bf16* src = U + (t0_ - 128 + ki) * INW; kreg[it] = *(const u32x4*)(src + U_AK + hk_ * 64 + c * 8); vreg[it] = *(const u32x4*)(src + U_AV + hk_ * 64 + c * 8); } } } while (0)
    int unit = F.wg;
    if (unit < NU) SWA_LOAD(unit);
    for (; unit < NU; unit += F.G) {
        const int hk = unit & 1, bn = unit >> 1, nb = bn & (NCH - 1);
        const size_t t0 = (size_t)bn * 128;
#pragma unroll
        for (int it = 0; it < 4; ++it) { const int q = F.tid + NTHREADS * it, ki = q >> 3, c = q & 7; *(LAS u32x4*)(Ks + ki * AS + c * 16) = kreg[it]; *(LAS u32x4*)(Vs + ki * AS + c * 16) = vreg[it]; }
        __syncthreads();
        const int gq = F.wave >> 1, hq = hk * 4 + gq;
        bf16x8 qn0, qn1;
        { const int iq = 16 * ((F.wave & 1) * 4) + i; const bf16* qsrc = U + (t0 + iq) * INW + U_AQ + hq * 64 + 8 * g; qn0 = *(const bf16x8*)qsrc; qn1 = *(const bf16x8*)(qsrc + 32); }
        { const int nu = unit + F.G; if (nu < NU) SWA_LOAD(nu); }
        constexpr float L2E = 1.4426950408889634f;
        const float sink2 = a.sinks[hq] * L2E;
        float bz[9][4];
#pragma unroll
        for (int t = 0; t < 9; ++t)
#pragma unroll
            for (int r = 0; r < 4; ++r) { const int dist = 128 - 16 * t + i - 4 * g - r; bz[t][r] = (dist >= 0 && dist < 128) ? tb[hq * 128 + (dist & 127)] * L2E : -3.0e38f; }
#pragma unroll 1
        for (int it = 0; it < 4; ++it) {
            const int qg = (F.wave & 1) * 4 + it, q0 = 16 * qg, iq = q0 + i;
            const bf16x8 qf0 = qn0, qf1 = qn1;
            if (it < 3) { const bf16* qsrc = U + (t0 + iq + 16) * INW + U_AQ + hq * 64 + 8 * g; qn0 = *(const bf16x8*)qsrc; qn1 = *(const bf16x8*)(qsrc + 32); }
            f32x4 sc[10];
            float mx = sink2;
#pragma unroll
            for (int t = 0; t < 9; ++t) {
                const int krow = 16 * (qg + t) + i;
                f32x4 s = (f32x4){0.f, 0.f, 0.f, 0.f};
                s = MFMA16(row_frag(Ks, AS, krow, 8 * g), qf0, s);
                s = MFMA16(row_frag(Ks, AS, krow, 32 + 8 * g), qf1, s);
                const bool dead = (nb == 0) && (qg + t < 8);
#pragma unroll
                for (int r = 0; r < 4; ++r) { const float v = dead ? -3.0e38f : s[r] * (0.125f * L2E) + bz[t][r]; s[r] = v; mx = fmaxf(mx, v); }
                sc[t] = s;
            }
            mx = fmaxf(mx, __shfl_xor(mx, 16)); mx = fmaxf(mx, __shfl_xor(mx, 32));
            float sum = 0.f;
#pragma unroll
            for (int t = 0; t < 9; ++t)
#pragma unroll
                for (int r = 0; r < 4; ++r) { const float p = __builtin_amdgcn_exp2f(sc[t][r] - mx); sc[t][r] = p; sum += p; }
            sc[9] = (f32x4){0.f, 0.f, 0.f, 0.f};
            sum += __shfl_xor(sum, 16); sum += __shfl_xor(sum, 32);
            const float inv = 1.0f / (sum + __builtin_amdgcn_exp2f(sink2 - mx));
            f32x4 o[4];
#pragma unroll
            for (int et = 0; et < 4; ++et) o[et] = (f32x4){0.f, 0.f, 0.f, 0.f};
#pragma unroll
            for (int s2 = 0; s2 < 5; ++s2) {
                const bf16x8 pf = pack8(sc[2 * s2], sc[2 * s2 + 1]);
                const int ka = 16 * (qg + 2 * s2) + 4 * g, kb = (s2 < 4) ? ka + 16 : ka;
#pragma unroll
                for (int et = 0; et < 4; ++et) o[et] = MFMA16(tr_frag(Vs, AS, ka, kb, 16 * et, lane), pf, o[et]);
            }
            bf16* dst = MIX + (t0 + iq) * DM + 512 + hq * 64 + 4 * g;
#pragma unroll
            for (int et = 0; et < 4; ++et) { u32x2 w; w.x = cvt_pk(o[et][0] * inv, o[et][1] * inv); w.y = cvt_pk(o[et][2] * inv, o[et][3] * inv); *(u32x2*)(dst + 16 * et) = w; }
        }
        __syncthreads();
    }
#undef SWA_LOAD
}

__device__ __forceinline__ void ret_scan(const Args& a, const Frame& F) {
    const bf16* KVS = (const bf16*)(a.ws + WS_KVS);
    bf16* ST = (bf16*)(a.ws + WS_ST);
    const int gt = F.wg * NTHREADS + F.tid;
    const int b = gt >> 15, p = gt & 32767, h = p >> 13;
    const float cd = __expf(128.0f * __logf(1.0f - exp2f(-5.0f - (float)h)));
    const size_t base = (size_t)b * NCH * 65536 + 2 * (size_t)p;
    float s0 = 0.f, s1 = 0.f;
    for (int n0 = 0; n0 < NCH; n0 += 16) {
        unsigned kv[16];
#pragma unroll
        for (int j = 0; j < 16; ++j) kv[j] = *(const unsigned*)(KVS + base + (size_t)(n0 + j) * 65536);
#pragma unroll
        for (int j = 0; j < 16; ++j) { *(unsigned*)(ST + base + (size_t)(n0 + j) * 65536) = pk2(s0, s1); s0 = s0 * cd + bflo(kv[j]); s1 = s1 * cd + bfhi(kv[j]); }
    }
}

__device__ __forceinline__ void ret_out_phase(const Args& a, const Frame& F) {
    const bf16* U = (const bf16*)(a.ws + WS_U);
    const bf16* ST = (const bf16*)(a.ws + WS_ST);
    bf16* MIX = (bf16*)(a.ws + WS_MIX);
    LAS unsigned char* Qt = F.lds; LAS unsigned char* Kt = F.lds + TILE_B; LAS unsigned char* Vt = F.lds + 2 * TILE_B; LAS unsigned char* Rt = F.lds + 3 * TILE_B;
    constexpr int NU = NB * NCH * 4;
    TileRegs rq, rk, rv, rr;
    int unit = F.wg;
    if (unit < NU) { const size_t t0 = (size_t)(unit >> 2) * 128; const int h = unit & 3;
        tile_load(rq, U + t0 * INW + U_RQ + h * 128, INW, F.tid); tile_load(rk, U + t0 * INW + U_RK + h * 128, INW, F.tid); tile_load(rv, U + t0 * INW + U_RV + h * 128, INW, F.tid); tile_load(rr, ST + (size_t)unit * 16384, 128, F.tid); }
    for (; unit < NU; unit += F.G) {
    const int h = unit & 3, bn = unit >> 2;
    const size_t t0 = (size_t)bn * 128;
    const float lgh = __logf(1.0f - exp2f(-5.0f - (float)h));
    tile_store<2>(Qt, rq, F.tid, lgh); tile_store<3>(Kt, rk, F.tid, lgh); tile_store<0>(Vt, rv, F.tid, 0.f); tile_store<0>(Rt, rr, F.tid, 0.f);
    __syncthreads();
    { const int nu = unit + F.G;
      if (nu < NU) { const size_t tn = (size_t)(nu >> 2) * 128; const int hn = nu & 3;
        tile_load(rq, U + tn * INW + U_RQ + hn * 128, INW, F.tid); tile_load(rk, U + tn * INW + U_RK + hn * 128, INW, F.tid); tile_load(rv, U + tn * INW + U_RV + hn * 128, INW, F.tid); tile_load(rr, ST + (size_t)nu * 16384, 128, F.tid); } }
    const int lane = F.lane, g = lane >> 4, i = lane & 15, w = F.wave, c = 16 * w + i;
    u32x2 gwv[8];
    { const bf16* gsrc = U + (t0 + c) * INW + U_RG + h * 128 + 4 * g;
#pragma unroll
      for (int et = 0; et < 8; ++et) gwv[et] = *(const u32x2*)(gsrc + 16 * et); }
    bf16x8 qf[4];
#pragma unroll
    for (int s = 0; s < 4; ++s) qf[s] = row_frag(Qt, TS, c, 32 * s + 8 * g);
    f32x4 st[8];
#pragma unroll
    for (int mt = 0; mt < 8; ++mt) {
        f32x4 s = (f32x4){0.f, 0.f, 0.f, 0.f};
        if (mt <= w) {
#pragma unroll
            for (int ks = 0; ks < 4; ++ks) s = MFMA16(row_frag(Kt, TS, 16 * mt + i, 32 * ks + 8 * g), qf[ks], s);
            if (mt == w) {
#pragma unroll
                for (int r = 0; r < 4; ++r) s[r] = (i >= 4 * g + r) ? s[r] : 0.f;
            }
        }
        st[mt] = s;
    }
    f32x4 o1[8], o2[8];
#pragma unroll
    for (int et = 0; et < 8; ++et) { o1[et] = (f32x4){0.f, 0.f, 0.f, 0.f}; o2[et] = (f32x4){0.f, 0.f, 0.f, 0.f}; }
#pragma unroll
    for (int s2 = 0; s2 < 4; ++s2) {
        if (2 * s2 <= w) {
            const bf16x8 pf = pack8(st[2 * s2], st[2 * s2 + 1]);
            const int ka = 32 * s2 + 4 * g, kb = ka + 16;
#pragma unroll
            for (int et = 0; et < 8; ++et) o1[et] = MFMA16(tr_frag(Vt, TS, ka, kb, 16 * et, lane), pf, o1[et]);
        }
    }
#pragma unroll
    for (int ks = 0; ks < 4; ++ks)
#pragma unroll
        for (int et = 0; et < 8; ++et) o2[et] = MFMA16(row_frag(Rt, TS, 16 * et + i, 32 * ks + 8 * g), qf[ks], o2[et]);
    const float qd = __expf(lgh);
    float ss = 0.f;
#pragma unroll
    for (int et = 0; et < 8; ++et)
#pragma unroll
        for (int r = 0; r < 4; ++r) { const float v = o1[et][r] + qd * o2[et][r]; o1[et][r] = v; ss += v * v; }
    ss += __shfl_xor(ss, 16); ss += __shfl_xor(ss, 32);
    const float rstd = 1.0f / sqrtf(ss * (1.0f / 128.0f) + EPS);
    bf16* dst = MIX + (t0 + c) * DM + h * 128 + 4 * g;
    const float* rg = a.ret_g + h * 128 + 4 * g;
#pragma unroll
    for (int et = 0; et < 8; ++et) {
        const u32x2 gw = gwv[et]; const f32x4 gn = *(const f32x4*)(rg + 16 * et);
        const float z[4] = {bflo(gw.x), bfhi(gw.x), bflo(gw.y), bfhi(gw.y)};
        float y[4];
#pragma unroll
        for (int r = 0; r < 4; ++r) y[r] = o1[et][r] * rstd * gn[r] * (z[r] * sigmoidf_(z[r]));
        u32x2 wv; wv.x = cvt_pk(y[0], y[1]); wv.y = cvt_pk(y[2], y[3]); *(u32x2*)(dst + 16 * et) = wv;
    }
    __syncthreads();
    }
}

__device__ __forceinline__ void p6_router(const Args& a, const Frame& F) {
    LAS int* hist = (LAS int*)F.lds;
    if (F.tid < 32) hist[F.tid] = 0;
    __syncthreads();
    const float* RP = (const float*)(a.ws + WS_RP);
    int* TOPI = (int*)(a.ws + WS_MISC + MS_TOPI); float* GATE = (float*)(a.ws + WS_MISC + MS_GATE); float* RSTD = (float*)(a.ws + WS_MISC + MS_RSTD);
    const int e = F.lane & 31, half = F.lane >> 5;
    const float my_b = a.b_router[e];
    const int rows_per_wg = NTOK / F.G;
    float prn[16], psn[16];
    { const int t = F.wg * rows_per_wg + F.wave * 2 + half;
#pragma unroll
      for (int q = 0; q < 16; ++q) { const float* rp = RP + ((size_t)q * NTOK + t) * 36; prn[q] = rp[e]; psn[q] = rp[32]; } }
    for (int it = 0; it < rows_per_wg / 16; ++it) {
        const int t = F.wg * rows_per_wg + it * 16 + F.wave * 2 + half;
        float raw = 0.f, ssq = 0.f;
#pragma unroll
        for (int q = 0; q < 16; ++q) { raw += prn[q]; ssq += psn[q]; }
        if (it + 1 < rows_per_wg / 16) {
#pragma unroll
            for (int q = 0; q < 16; ++q) { const float* rp = RP + ((size_t)q * NTOK + t + 16) * 36; prn[q] = rp[e]; psn[q] = rp[32]; } }
        const float rstd = 1.0f / sqrtf(ssq * (1.0f / DM) + EPS);
        float val = raw * rstd + my_b;
        float tv[4]; int ti[4];
#pragma unroll
        for (int k = 0; k < 4; ++k) {
            float m = val;
#pragma unroll
            for (int o = 1; o < 32; o <<= 1) m = fmaxf(m, __shfl_xor(m, o));
            int idx = (val == m) ? e : 99;
#pragma unroll
            for (int o = 1; o < 32; o <<= 1) { const int x2 = __shfl_xor(idx, o); idx = x2 < idx ? x2 : idx; }
            tv[k] = m; ti[k] = idx; if (e == idx) val = -3.0e38f;
        }
        if (e == 0) {
            const float e1 = __expf(tv[1] - tv[0]), e2 = __expf(tv[2] - tv[0]), e3 = __expf(tv[3] - tv[0]); const float inv = 1.0f / (1.0f + e1 + e2 + e3);
            *(int4*)(TOPI + (size_t)t * 4) = make_int4(ti[0], ti[1], ti[2], ti[3]);
            *(f32x4*)(GATE + (size_t)t * 4) = (f32x4){inv, e1 * inv, e2 * inv, e3 * inv};
            RSTD[t] = rstd;
#pragma unroll
            for (int k = 0; k < 4; ++k) atomicAdd((int*)(hist + ti[k]), 1);
        }
    }
    __syncthreads();
    if (F.tid < 32) ((int*)(a.ws + WS_MISC + MS_WGCNT))[F.wg * 32 + F.tid] = hist[F.tid];
    __syncthreads();
}

__device__ __forceinline__ void p7_assign(const Args& a, const Frame& F) {
    LAS int* cnt = (LAS int*)F.lds;
    LAS int* tot = cnt + 256 * 32; LAS int* base = tot + 32; LAS int* poff = base + 32; LAS int* cursor = poff + 36;
    const int* WGCNT = (const int*)(a.ws + WS_MISC + MS_WGCNT);
    for (int i = F.tid; i < 256 * 32; i += NTHREADS) cnt[i] = WGCNT[i];
    __syncthreads();
    LAS int* part = cursor + 32;
    { const int e = F.tid & 31, pt = F.tid >> 5; int s2 = 0, b2 = 0;
#pragma unroll
      for (int j = 0; j < 16; ++j) { const int w = pt * 16 + j; const int c = cnt[w * 32 + e]; s2 += c; b2 += (w < F.wg) ? c : 0; }
      part[pt * 32 + e] = s2; part[512 + pt * 32 + e] = b2; }
    __syncthreads();
    if (F.tid < 32) { int s2 = 0, b2 = 0;
#pragma unroll
        for (int pt = 0; pt < 16; ++pt) { s2 += part[pt * 32 + F.tid]; b2 += part[512 + pt * 32 + F.tid]; }
        tot[F.tid] = s2; base[F.tid] = b2; cursor[F.tid] = 0; }
    __syncthreads();
    if (F.tid == 0) { int o = 0; for (int e = 0; e < 32; ++e) { poff[e] = o; o += (tot[e] + 255) & ~255; } poff[32] = o; }
    __syncthreads();
    int* ROWTOK = (int*)(a.ws + WS_MISC + MS_ROWTOK); int* ROWSLOT = (int*)(a.ws + WS_MISC + MS_ROWSLOT); int* TILEE = (int*)(a.ws + WS_MISC + MS_TILEE); int* META = (int*)(a.ws + WS_MISC + MS_META);
    const int* TOPI = (const int*)(a.ws + WS_MISC + MS_TOPI); const float* RSTD = (const float*)(a.ws + WS_MISC + MS_RSTD); float* ROWSCALE = (float*)(a.ws + WS_MISC + MS_ROWSCALE);
    { const int slot = F.wg * 512 + F.tid, e = TOPI[slot]; const int rank = atomicAdd((int*)(cursor + e), 1); const int dest = poff[e] + base[e] + rank; ROWTOK[dest] = slot >> 2; ROWSLOT[dest] = slot; ROWSCALE[dest] = RSTD[slot >> 2] * (1.0f / (F8_WSCALE * F8_ASCALE)); }
    if (F.wg < 32) { const int e = F.wg, p0 = poff[e], p1 = poff[e + 1];
        for (int r = p0 + tot[e] + F.tid; r < p1; r += NTHREADS) { ROWTOK[r] = NTOK; ROWSLOT[r] = -1; ROWSCALE[r] = 0.f; }
        for (int tl = (p0 >> 8) + F.tid; tl < (p1 >> 8); tl += NTHREADS) TILEE[tl] = e; }
    if (F.wg == 0 && F.tid == 0) META[0] = poff[32] >> 8;
    __syncthreads();
}

__device__ __forceinline__ void p10_combine(const Args& a, const Frame& F) {
    const bf16* H1B = (const bf16*)(a.ws + WS_H1B); const unsigned char* Y = a.ws + WS_Y; const float* GATE = (const float*)(a.ws + WS_MISC + MS_GATE);
    bf16* H2B = (bf16*)(a.ws + WS_H2B);
    const int gw = F.wg * NWAVES + F.wave, NGW = F.G * NWAVES, lane = F.lane;
    for (int t = gw; t < NTOK; t += NGW) {
        const f32x4 gt = *(const f32x4*)(GATE + (size_t)t * 4);
#pragma unroll
        for (int half = 0; half < 2; ++half) {
            const int c0 = half * 512 + 8 * lane;
            const u32x4 hw = *(const u32x4*)(H1B + (size_t)t * DM + c0);
            float v[8] = {bflo(hw.x), bfhi(hw.x), bflo(hw.y), bfhi(hw.y), bflo(hw.z), bfhi(hw.z), bflo(hw.w), bfhi(hw.w)};
#pragma unroll
            for (int k = 0; k < 4; ++k) { const u32x2 y = *(const u32x2*)(Y + ((size_t)t * 4 + k) * DM + c0); const float gk = gt[k] * (1.0f / gx::F8_YSCALE);
                const f32x2 y0 = __builtin_amdgcn_cvt_pk_f32_fp8((int)y.x, false), y1 = __builtin_amdgcn_cvt_pk_f32_fp8((int)y.x, true), y2 = __builtin_amdgcn_cvt_pk_f32_fp8((int)y.y, false), y3 = __builtin_amdgcn_cvt_pk_f32_fp8((int)y.y, true);
                v[0] += gk * y0[0]; v[1] += gk * y0[1]; v[2] += gk * y1[0]; v[3] += gk * y1[1]; v[4] += gk * y2[0]; v[5] += gk * y2[1]; v[6] += gk * y3[0]; v[7] += gk * y3[1]; }
            u32x4 w; w.x = pk2(v[0], v[1]); w.y = pk2(v[2], v[3]); w.z = pk2(v[4], v[5]); w.w = pk2(v[6], v[7]);
            *(u32x4*)(H2B + (size_t)t * DM + c0) = w;
        }
    }
}

__device__ __forceinline__ void p12_final(const Args& a, const Frame& F) {
    const bf16* T = (const bf16*)(a.ws + WS_MIX); const bf16* H2B = (const bf16*)(a.ws + WS_H2B);
    const int gw = F.wg * NWAVES + F.wave, NGW = F.G * NWAVES, lane = F.lane;
    float gp[16], gf[16];
#pragma unroll
    for (int half = 0; half < 2; ++half)
#pragma unroll
        for (int q = 0; q < 2; ++q) { const f32x4 x1 = *(const f32x4*)(a.g_ple + half * 512 + 8 * lane + 4 * q), x2 = *(const f32x4*)(a.g_final + half * 512 + 8 * lane + 4 * q);
#pragma unroll
            for (int r = 0; r < 4; ++r) { gp[half * 8 + q * 4 + r] = x1[r]; gf[half * 8 + q * 4 + r] = x2[r]; } }
    for (int t = gw; t < NTOK; t += NGW) {
        float tv[16], hv[16];
#pragma unroll
        for (int half = 0; half < 2; ++half) { const int c0 = half * 512 + 8 * lane;
            const u32x4 tw = *(const u32x4*)(T + (size_t)t * DM + c0), hw = *(const u32x4*)(H2B + (size_t)t * DM + c0);
            const unsigned tt[4] = {tw.x, tw.y, tw.z, tw.w}, hh[4] = {hw.x, hw.y, hw.z, hw.w};
#pragma unroll
            for (int q = 0; q < 4; ++q) { tv[half * 8 + 2 * q] = bflo(tt[q]); tv[half * 8 + 2 * q + 1] = bfhi(tt[q]); hv[half * 8 + 2 * q] = bflo(hh[q]); hv[half * 8 + 2 * q + 1] = bfhi(hh[q]); } }
        float s = 0.f;
#pragma unroll
        for (int i = 0; i < 16; ++i) s += tv[i] * tv[i];
        const float r1 = 1.0f / sqrtf(wave_sum(s) * (1.0f / DM) + EPS);
        float s2 = 0.f;
#pragma unroll
        for (int i = 0; i < 16; ++i) { hv[i] += tv[i] * r1 * gp[i]; s2 += hv[i] * hv[i]; }
        const float r2 = 1.0f / sqrtf(wave_sum(s2) * (1.0f / DM) + EPS);
#pragma unroll
        for (int half = 0; half < 2; ++half) { const int c0 = half * 512 + 8 * lane;
#pragma unroll
            for (int q = 0; q < 2; ++q) { const int b = half * 8 + 4 * q;
                *(f32x4*)(a.out + (size_t)t * DM + c0 + 4 * q) = (f32x4){hv[b] * r2 * gf[b], hv[b + 1] * r2 * gf[b + 1], hv[b + 2] * r2 * gf[b + 2], hv[b + 3] * r2 * gf[b + 3]}; } }
    }
}

constexpr int N_PHASES = 13;
__global__ void __launch_bounds__(NTHREADS, 2) hymba_fwd(Args a) {
    extern __shared__ __attribute__((aligned(16))) unsigned char lds_raw[];
    Frame F;
    F.lds = (LAS unsigned char*)lds_raw;
    F.tid = threadIdx.x; F.lane = F.tid & 63; F.wave = __builtin_amdgcn_readfirstlane(F.tid >> 6);
    F.G = gridDim.x; F.wg = blockIdx.x;
    volatile LAS unsigned* MISC = (volatile LAS unsigned*)(F.lds + MISC_OFF);
    for (int u = F.tid; u < (LDS_BYTES - MISC_OFF) / 4; u += NTHREADS) ((LAS unsigned*)(F.lds + MISC_OFF))[u] = 0u;
    __syncthreads();
    unsigned* ctl = (unsigned*)(a.ws + WS_CTL);
    XcdBarrier bar; bar.bar = ctl + CW_BAR; bar.x = 0; bar.st = nullptr;
    if (MK_N_LAUNCHES == 1) bar = xcd_barrier_post(ctl + CW_BAR, MISC + 8);
    const int lo = a.ph_lo, hi = a.ph_hi;
#ifdef ONLY_PHASE
#define IN(k) ((k) == ONLY_PHASE && lo <= (k) && (k) < hi)
#else
#define IN(k) (lo <= (k) && (k) < hi)
#endif
#define SEAM(k) do { if (IN(k) && IN((k) + 1)) xcd_barrier(bar); F.tid = opaque_tid(); F.lane = F.tid & 63; F.wave = __builtin_amdgcn_readfirstlane(F.tid >> 6); } while (0)
    unsigned char* ws = a.ws;

    if (IN(0)) { p0_prologue(a, F); } SEAM(0);

    if (IN(1)) {
        { gx::SchedDense S{NTOK / 256, INW / 256, F.G, F.wg, DM * 2, (const char*)(ws + WS_WIN)};
          gx::EpiU E{(bf16*)(ws + WS_U), (const float*)(ws + WS_MISC + MS_BIN), (const float*)(ws + WS_ROPE)};
          gx::gemm<false>(F.lds, (const char*)(ws + WS_XN), DM * 2, S, E); }
        if (F.wg >= F.G / 2) {
            gx::SchedDense S{NTOK / 256, DM / 256, F.G / 2, F.wg - F.G / 2, PLE * 2, (const char*)(ws + WS_WP)};
            gx::EpiBf16Plain E{(bf16*)(ws + WS_PJ), DM};
            gx::gemm<false>(F.lds, (const char*)(ws + WS_PB), PLE * 2, S, E);
        }
    } SEAM(1);

    if (IN(2)) {
        ret_kv_phase(a, F);
        swa_phase(a, F);
    } SEAM(2);

    if (IN(3)) {
        ret_scan(a, F);
    } SEAM(3);

    if (IN(4)) { ret_out_phase(a, F); } SEAM(4);

    if (IN(5)) {
        gx::SchedDense S{NTOK / 256, DM / 256, F.G, F.wg, DM * 2, (const char*)(ws + WS_WOUT)};
        gx::EpiRouter E{a.x, (bf16*)(ws + WS_H1B), (unsigned char*)(ws + WS_H1F8), (const bf16*)(ws + WS_MISC + MS_WRB), (float*)(ws + WS_RP)};
        gx::gemm<false>(F.lds, (const char*)(ws + WS_MIX), DM * 2, S, E);
    } SEAM(5);

    if (IN(6)) { p6_router(a, F); } SEAM(6);
    if (IN(7)) { p7_assign(a, F); } SEAM(7);

    if (IN(8)) {
        const int ntiles = __builtin_amdgcn_readfirstlane(__hip_atomic_load((const int*)(ws + WS_MISC + MS_META), __ATOMIC_RELAXED, __HIP_MEMORY_SCOPE_AGENT));
        gx::SchedMoe<true> S{ntiles, UPW / 256, F.G, F.wg, DM, (const char*)(ws + WS_WUP), (size_t)UPW * DM, (const int*)(ws + WS_MISC + MS_TILEE), (const int*)(ws + WS_MISC + MS_ROWTOK), (LAS int*)(F.lds + gx::STAGE_BYTES)};
        S.preload(F.tid);
        gx::EpiUp E{(unsigned char*)(ws + WS_ACT), (const float*)(ws + WS_MISC + MS_BUPP), (const float*)(ws + WS_MISC + MS_ROWSCALE)};
        gx::gemm<true>(F.lds, (const char*)(ws + WS_H1F8), DM, S, E);
    } SEAM(8);

    if (IN(9)) {
        const int ntiles = __builtin_amdgcn_readfirstlane(__hip_atomic_load((const int*)(ws + WS_MISC + MS_META), __ATOMIC_RELAXED, __HIP_MEMORY_SCOPE_AGENT));
        gx::SchedMoe<false> S{ntiles, DM / 256, F.G, F.wg, DFF, (const char*)(ws + WS_WDN), (size_t)DM * DFF, (const int*)(ws + WS_MISC + MS_TILEE), nullptr, (LAS int*)(F.lds + gx::STAGE_BYTES)};
        S.preload(F.tid);
        gx::EpiDown E{(unsigned char*)(ws + WS_Y), a.b_down, (const int*)(ws + WS_MISC + MS_ROWSLOT)};
        gx::gemm<true>(F.lds, (const char*)(ws + WS_ACT), DFF, S, E);
    } SEAM(9);

    if (IN(10)) { p10_combine(a, F); } SEAM(10);

    if (IN(11)) {
        gx::SchedDense S{NTOK / 256, DM / 256, F.G, F.wg, DM * 2, (const char*)(ws + WS_WG)};
        gx::EpiGate E{(const bf16*)(ws + WS_PJ), (bf16*)(ws + WS_MIX)};
        gx::gemm<false>(F.lds, (const char*)(ws + WS_H2B), DM * 2, S, E);
    } SEAM(11);

    if (IN(12)) { p12_final(a, F); }
#undef IN
#undef SEAM
}

extern "C" void kernel_launch(void* const* d_in, const int* in_sizes, int n_in, void* d_out, int out_size, void* d_ws, size_t ws_size, hipStream_t stream) {
    static int ready = 0;
    if (ready == 0) {
        if (n_in != 21 || in_sizes[0] != NTOK * DM || out_size != NTOK * DM || ws_size < WS_END) { fprintf(stderr, "kernel_launch: unexpected shapes (n_in %d, ws %zu)\n", n_in, ws_size); ready = -1; return; }
        if (hipFuncSetAttribute((const void*)hymba_fwd, hipFuncAttributeMaxDynamicSharedMemorySize, LDS_BYTES) != hipSuccess) { fprintf(stderr, "kernel_launch: hipFuncSetAttribute failed\n"); ready = -1; return; }
        int per_cu = 0;
        if (hipOccupancyMaxActiveBlocksPerMultiprocessor(&per_cu, (const void*)hymba_fwd, NTHREADS, LDS_BYTES) != hipSuccess || per_cu < 1) fprintf(stderr, "kernel_launch: occupancy query says %d\n", per_cu);
        (void)hipGetLastError();
        ready = 1;
    }
    if (ready < 0) return;
    (void)hipMemsetAsync((char*)d_ws + WS_CTL, 0, CTL_ZERO_BYTES, stream);
    Args a{};
    a.x = (const float*)d_in[0]; a.p = (const float*)d_in[1]; a.positions = (const int*)d_in[2]; a.rel_bias = (const float*)d_in[3]; a.g_mix = (const float*)d_in[4];
    a.w_in = (const float*)d_in[5]; a.b_in = (const float*)d_in[6]; a.ret_g = (const float*)d_in[7]; a.sinks = (const float*)d_in[8]; a.w_out = (const float*)d_in[9];
    a.g_moe = (const float*)d_in[10]; a.w_router = (const float*)d_in[11]; a.b_router = (const float*)d_in[12]; a.w_up = (const float*)d_in[13]; a.b_up = (const float*)d_in[14];
    a.w_down = (const float*)d_in[15]; a.b_down = (const float*)d_in[16]; a.w_gate = (const float*)d_in[17]; a.w_proj = (const float*)d_in[18]; a.g_ple = (const float*)d_in[19]; a.g_final = (const float*)d_in[20];
    a.out = (float*)d_out; a.ws = (unsigned char*)d_ws;
    for (int j = 0; j < 64; ++j) a.inv[j] = (float)pow(10000.0, -(double)j / 64.0);
    for (int n = 0; n < 128; ++n) { int bkt = n; if (n >= 16) { const float v = logf((float)n / 16.0f) / (float)log(8.0) * 16.0f; bkt = 16 + (int)v; if (bkt > 31) bkt = 31; } a.bucket[n] = (unsigned char)bkt; }
#if MK_N_LAUNCHES == 1
    a.ph_lo = 0; a.ph_hi = N_PHASES;
    hipLaunchKernelGGL(hymba_fwd, dim3(GRID), dim3(NTHREADS), LDS_BYTES, stream, a);
#else
    for (int ph = 0; ph < N_PHASES; ++ph) { a.ph_lo = ph; a.ph_hi = ph + 1; hipLaunchKernelGGL(hymba_fwd, dim3(GRID), dim3(NTHREADS), LDS_BYTES, stream, a);
#ifdef REPEAT_PHASE
        if (ph == REPEAT_PHASE) for (int r = 0; r < REPEAT_N; ++r) hipLaunchKernelGGL(hymba_fwd, dim3(GRID), dim3(NTHREADS), LDS_BYTES, stream, a);
#endif
    }
#endif
}
```

```cpp
#include <hip/hip_runtime.h>
#include <cstdio>
#include <cstdint>
#include <cmath>

#ifndef MK_N_LAUNCHES
#define MK_N_LAUNCHES 1
#endif

#define LAS __attribute__((address_space(3)))
#define GAS __attribute__((address_space(1)))
typedef unsigned short bf16;
typedef short bf16x8 __attribute__((ext_vector_type(8)));
typedef short s16x4 __attribute__((ext_vector_type(4)));
typedef float f32x4 __attribute__((ext_vector_type(4)));
typedef float f32x16 __attribute__((ext_vector_type(16)));
typedef float f32x2 __attribute__((ext_vector_type(2)));
typedef unsigned u32x4 __attribute__((ext_vector_type(4)));
typedef unsigned u32x2 __attribute__((ext_vector_type(2)));
typedef GAS unsigned gu32;

constexpr int NB = 4, SEQ = 8192, NTOK = NB * SEQ, DM = 1024, INW = 2816, PLE = 256;
constexpr int NEXP = 32, TOPK = 4, DFF = 1024, UPW = 2 * DFF;
constexpr int NCH = SEQ / 128;
constexpr int CAP_ROWS = NTOK * TOPK + NEXP * 256;
constexpr int MAX_TILES = CAP_ROWS / 256;
constexpr float EPS = 1e-5f;
constexpr int NWAVES = 8, NTHREADS = 512, GRID = 256;
constexpr float F8_WSCALE = 64.0f, F8_ASCALE = 8.0f;
constexpr int U_RQ = 0, U_RK = 512, U_RV = 1024, U_RG = 1536, U_AQ = 2048, U_AK = 2560, U_AV = 2688;

constexpr size_t MiB = 1u << 20;
constexpr size_t WS_CTL = 0, CTL_ZERO_BYTES = 32 * 1024;
constexpr size_t WS_WIN = 1 * MiB;
constexpr size_t WS_WOUT = 7 * MiB;
constexpr size_t WS_WG = 9 * MiB;
constexpr size_t WS_WP = 11 * MiB;
constexpr size_t WS_MISC = 12 * MiB;
constexpr size_t WS_ROPE = 16 * MiB;
constexpr size_t WS_WDN = 32 * MiB;
constexpr size_t WS_REGB = 96 * MiB;
constexpr size_t WS_WUP = WS_REGB;
constexpr size_t WS_XN = WS_WUP + 128 * MiB;
constexpr size_t WS_PB = WS_XN + 65 * MiB;
constexpr size_t WS_MIX = WS_PB + 16 * MiB;
constexpr size_t WS_Y = WS_REGB;
constexpr size_t WS_REGA = WS_MIX + 64 * MiB;
constexpr size_t WS_U = WS_REGA;
constexpr size_t WS_KVS = WS_U + 176 * MiB;
constexpr size_t WS_ST = WS_KVS + 64 * MiB;
constexpr size_t WS_ACT = WS_REGA;
constexpr size_t WS_H2B = WS_REGA;
constexpr size_t WS_H2F8 = WS_REGA + 64 * MiB;
constexpr size_t WS_PJ = WS_REGA + 272 * MiB;
constexpr size_t WS_H1B = WS_PJ + 64 * MiB;
constexpr size_t WS_H1F8 = WS_H1B + 65 * MiB;
constexpr size_t WS_END = WS_H1F8 + 33 * MiB;
static_assert(WS_Y + 256 * MiB <= WS_REGA, "Y overlays only region B");
static_assert(WS_END <= 1024 * MiB, "workspace");
constexpr size_t MS_BIN = 0;
constexpr size_t MS_TOPI = 64 * 1024;
constexpr size_t MS_GATE = MS_TOPI + 512 * 1024;
constexpr size_t MS_WGCNT = MS_GATE + 512 * 1024;
constexpr size_t MS_ROWTOK = MS_WGCNT + 64 * 1024;
constexpr size_t MS_ROWSLOT = MS_ROWTOK + 576 * 1024;
constexpr size_t MS_TILEE = MS_ROWSLOT + 576 * 1024;
constexpr size_t MS_META = MS_TILEE + 4096;
constexpr size_t MS_WRB = MS_META + 4096;
constexpr size_t MS_RSTD = MS_WRB + 128 * 1024;
constexpr size_t MS_ROWSCALE = MS_RSTD + 128 * 1024;
constexpr size_t MS_BUPP = MS_ROWSCALE + 576 * 1024;
static_assert(MS_BUPP + 256 * 1024 <= 4 * MiB, "misc");
constexpr size_t WS_RP = WS_KVS;
constexpr int CW_BAR = 4096;

constexpr int LDS_BYTES = 155648;
constexpr int MISC_OFF = 151 * 1024;
constexpr int MOE_AUX_OFF = 148 * 1024;
static_assert(131072 + 18 * 4 + 18 * 256 * 4 <= MOE_AUX_OFF && MOE_AUX_OFF + 2048 <= MISC_OFF, "MoE metadata and epilogue operands fit under the control words");

#define LDS_WAIT() asm volatile("s_waitcnt lgkmcnt(0)" ::: "memory")
#define VM_WAIT() asm volatile("s_waitcnt vmcnt(0)" ::: "memory")

__device__ __forceinline__ unsigned f2bf(float f) { unsigned u = __builtin_bit_cast(unsigned, f); return (u + 0x7fffu + ((u >> 16) & 1u)) >> 16; }
__device__ __forceinline__ unsigned pk2(float lo, float hi) { return f2bf(lo) | (f2bf(hi) << 16); }
typedef __bf16 bf16x2_t __attribute__((ext_vector_type(2)));
__device__ __forceinline__ unsigned cvt_pk(float lo, float hi) { const f32x2 v = {lo, hi}; return __builtin_bit_cast(unsigned, __builtin_convertvector(v, bf16x2_t)); }
__device__ __forceinline__ unsigned pk4_fp8(float a, float b, float c, float d) { int w = 0; w = __builtin_amdgcn_cvt_pk_fp8_f32(a, b, w, false); w = __builtin_amdgcn_cvt_pk_fp8_f32(c, d, w, true); return (unsigned)w; }
__device__ __forceinline__ float bflo(unsigned w) { return __builtin_bit_cast(float, w << 16); }
__device__ __forceinline__ float bfhi(unsigned w) { return __builtin_bit_cast(float, w & 0xffff0000u); }
__device__ __forceinline__ float wave_sum(float v) {
#pragma unroll
    for (int o = 1; o < 64; o <<= 1) v += __shfl_xor(v, o);
    return v;
}
__device__ __forceinline__ float wave_max(float v) {
#pragma unroll
    for (int o = 1; o < 64; o <<= 1) v = fmaxf(v, __shfl_xor(v, o));
    return v;
}
__device__ __forceinline__ int wave_min_i(int v) {
#pragma unroll
    for (int o = 1; o < 64; o <<= 1) { const int t = __shfl_xor(v, o); v = t < v ? t : v; }
    return v;
}
__device__ __forceinline__ int opaque_tid() { int t = threadIdx.x; asm volatile("" : "+v"(t)); return t; }
__device__ __forceinline__ float sigmoidf_(float z) { return __builtin_amdgcn_rcpf(1.0f + __expf(-z)); }

#define XB_TMO      128
#define XB_XCNT(j)  (256  + 64 * (j))
#define XB_XSUB(j)  (1280 + 64 * (j))
#define XB_XGEN(j)  (2304 + 64 * (j))
#define XB_TOP      3328
#define XB_TOPGEN   3392
#define XCD_BAR_WORDS 3456
#define XB_SPIN_CAP (1u << 18)
__device__ __forceinline__ unsigned xb_ld(unsigned* p)              { return __hip_atomic_load(p, __ATOMIC_RELAXED, __HIP_MEMORY_SCOPE_AGENT); }
__device__ __forceinline__ unsigned xb_add(unsigned* p, unsigned v) { return __hip_atomic_fetch_add(p, v, __ATOMIC_RELAXED, __HIP_MEMORY_SCOPE_AGENT); }
__device__ __forceinline__ unsigned xb_xcc_id() { return (unsigned)__builtin_amdgcn_s_getreg((3 << 11) | 20) & 0xFu; }
#define XB_SPIN(cond, bar) do { unsigned _sp = 0; while (cond) { __builtin_amdgcn_s_sleep(1); \
    if ((++_sp & 255u) == 0u) { if (xb_ld(&(bar)[XB_TMO])) break; if (_sp > XB_SPIN_CAP) { atomicAdd(&(bar)[XB_TMO], 1u); break; } } } } while (0)
struct XcdBarrier { unsigned* bar; unsigned x; volatile LAS unsigned* st; };
__device__ __forceinline__ XcdBarrier xcd_barrier_post(unsigned* bar, volatile LAS unsigned* st) {
    XcdBarrier b; b.bar = bar; b.x = xb_xcc_id(); b.st = st;
    if (threadIdx.x == 0) (void)xb_add(&bar[XB_XCNT(b.x)], 1u);
    return b;
}
__device__ __forceinline__ void xcd_barrier_complete(unsigned* bar, unsigned x, unsigned& nloc, unsigned& nx) {
    const unsigned G = gridDim.x * gridDim.y * gridDim.z;
    unsigned sum, cnt, mine, sp = 0u;
    for (;;) {
        sum = 0u; cnt = 0u; mine = 0u;
#pragma unroll
        for (unsigned j = 0; j < 16; ++j) { const unsigned c = xb_ld(&bar[XB_XCNT(j)]); sum += c; cnt += (c > 0u) ? 1u : 0u; mine = (j == x) ? c : mine; }
        if (sum == G) break;
        __builtin_amdgcn_s_sleep(1);
        if ((++sp & 255u) == 0u) { if (xb_ld(&bar[XB_TMO])) break; if (sp > XB_SPIN_CAP) { atomicAdd(&bar[XB_TMO], 1u); break; } }
    }
    nloc = mine > 0u ? mine : 1u; nx = cnt > 0u ? cnt : 1u;
}
__device__ __forceinline__ void xcd_barrier(const XcdBarrier& b) {
    asm volatile("s_waitcnt vmcnt(0)" ::: "memory");
    __syncthreads();
    if (threadIdx.x == 0) {
        unsigned* bar = b.bar;
        __builtin_amdgcn_s_waitcnt(0);
        unsigned nloc = b.st[0], nx = b.st[1];
        if (nloc == 0u) { xcd_barrier_complete(bar, b.x, nloc, nx); b.st[0] = nloc; b.st[1] = nx; }
        const unsigned old = xb_add(&bar[XB_XSUB(b.x)], 1u);
        const unsigned gen = old / nloc;
        if (old + 1u == (gen + 1u) * nloc) {
            __builtin_amdgcn_fence(__ATOMIC_RELEASE, "agent");
            asm volatile("s_waitcnt vmcnt(0)" ::: "memory");
            const unsigned og = xb_add(&bar[XB_TOP], 1u);
            const unsigned tg = og / nx;
            if (og + 1u == (tg + 1u) * nx) xb_add(&bar[XB_TOPGEN], 1u);
            else XB_SPIN(xb_ld(&bar[XB_TOPGEN]) == tg, bar);
            __builtin_amdgcn_fence(__ATOMIC_ACQUIRE, "agent");
            xb_add(&bar[XB_XGEN(b.x)], 1u);
            asm volatile("s_waitcnt vmcnt(0)" ::: "memory");
        } else {
            XB_SPIN(xb_ld(&bar[XB_XGEN(b.x)]) == gen, bar);
            __builtin_amdgcn_fence(__ATOMIC_ACQUIRE, "agent");
            asm volatile("s_waitcnt vmcnt(0)" ::: "memory");
        }
    }
    __syncthreads();
}

namespace gx {
constexpr int BM = 256, BK = 64, HALF = 128, HTB = HALF * BK * 2, STAGE_BYTES = 8 * HTB, NXCD = 8, WGM = 8;
__device__ __forceinline__ int lds_byte(int r, int c) { const int st = (r >> 4) * 2 + (c >> 5), rr = r & 15, cc = c & 31, ob = rr * 64 + cc * 2; return st * 1024 + (ob ^ (((ob >> 9) & 1) << 5)); }
__device__ __forceinline__ void stage_rc(int b, int& R, int& C) { const int st = b / 1024, sb = b % 1024, swz = sb ^ (((sb >> 9) & 1) << 5); R = (st >> 1) * 16 + swz / 64; C = (st & 1) * 32 + (swz % 64) / 2; }
__device__ __forceinline__ void stage_rc_f8(int b, int& R, int& Cb) { const int st = b / 1024, sb = b % 1024, swz = sb ^ (((sb >> 9) & 1) << 5); R = (st >> 1) * 16 + swz / 64; Cb = 32 * ((swz % 64) / 16) + 16 * (st & 1) + (swz % 16); }
__device__ __forceinline__ int bcol(int h, int R) { return 16 * (4 * (R >> 5) + ((R >> 2) & 3)) + 8 * h + 4 * ((R >> 4) & 1) + (R & 3); }
struct Unit { int pm, pn, e; unsigned B; };
__device__ __forceinline__ bool tile_order(int i, int G, int c, int nM, int nN, int& pm, int& pn) {
    const int nwg = nM * nN; const long L = (long)i * G + c; if (L >= nwg) return false;
    int wgid = (int)L; { const int q = nwg / NXCD, r = nwg % NXCD, xcd = wgid % NXCD, off = wgid / NXCD; wgid = (xcd < r ? xcd * (q + 1) : r * (q + 1) + (xcd - r) * q) + off; }
    const int nig = WGM * nN, gid = wgid / nig, fm = gid * WGM, gsz = (nM - fm) < WGM ? (nM - fm) : WGM;
    pm = fm + ((wgid % nig) % gsz); pn = (wgid % nig) / gsz; return true;
}
template <bool F8 = false>
struct SchedDenseT {
    int nM, nN, G, c, Kb; const char* Bt; int r0, nr;
    __device__ __forceinline__ bool next(int i, Unit& u) const { if (i >= nr || !tile_order(i + r0, G, c, nM, nN, u.pm, u.pn)) return false; u.e = 0; u.B = (unsigned)u.pn * 256u * (unsigned)Kb; return true; }
    __device__ __forceinline__ const char* wbase() const { return Bt; }
    __device__ __forceinline__ void finish(Unit& u, int, unsigned (&vo)[2][2], int tid) const {
#pragma unroll
        for (int i = 0; i < 2; ++i) { int R, Cb; if (F8) stage_rc_f8(tid * 16 + i * 8192, R, Cb); else { int C; stage_rc(tid * 16 + i * 8192, R, C); Cb = C * 2; }
#pragma unroll
            for (int h = 0; h < 2; ++h) vo[h][i] = (unsigned)((u.pm * 256 + h * 128 + R) * Kb + Cb); }
    }
};
typedef SchedDenseT<false> SchedDense;
constexpr int MOE_MAX_UNITS = 18;
template <bool GATHER>
struct SchedMoe {
    int nM, nN, G, c, Kb; const char* W; size_t estride; const int* tile_e; const int* rowtok; LAS int* meta;
    __device__ __forceinline__ bool next(int i, Unit& u) const { return tile_order(i, G, c, nM, nN, u.pm, u.pn); }
    __device__ __forceinline__ const char* wbase() const { return W; }
    __device__ __forceinline__ void preload(int tid) const {
        int ev[MOE_MAX_UNITS], rv[MOE_MAX_UNITS];
#pragma unroll
        for (int i = 0; i < MOE_MAX_UNITS; ++i) { Unit u; const bool ok = next(i, u); ev[i] = 0; rv[i] = 0;
            if (ok && tid == 0) ev[i] = __hip_atomic_load(tile_e + u.pm, __ATOMIC_RELAXED, __HIP_MEMORY_SCOPE_AGENT);
            if (ok && GATHER && tid < 256) rv[i] = rowtok[u.pm * 256 + tid]; }
#pragma unroll
        for (int i = 0; i < MOE_MAX_UNITS; ++i) { if (tid == 0) meta[i] = ev[i]; if (GATHER && tid < 256) meta[MOE_MAX_UNITS + i * 256 + tid] = rv[i]; }
        __syncthreads();
    }
    __device__ __forceinline__ void finish(Unit& u, int ord, unsigned (&vo)[2][2], int tid) const {
        u.e = __builtin_amdgcn_readfirstlane(meta[ord]); u.B = (unsigned)((size_t)u.e * estride) + (unsigned)u.pn * 256u * (unsigned)Kb;
#pragma unroll
        for (int i = 0; i < 2; ++i) { int R, Cb; stage_rc_f8(tid * 16 + i * 8192, R, Cb);
#pragma unroll
            for (int h = 0; h < 2; ++h) vo[h][i] = (unsigned)((GATHER ? meta[MOE_MAX_UNITS + ord * 256 + h * 128 + R] : (u.pm * 256 + h * 128 + R)) * Kb + Cb); }
    }
};
__device__ __forceinline__ void acc_zero(f32x16 (&acc)[2][2][2]) {
#pragma unroll
    for (int a = 0; a < 2; ++a)
#pragma unroll
        for (int b = 0; b < 2; ++b)
#pragma unroll
            for (int mh = 0; mh < 2; ++mh)
#pragma unroll
                for (int i = 0; i < 16; ++i) acc[a][b][mh][i] = 0.f;
}
__device__ __forceinline__ void acc_bias(f32x16 (&acc)[2][2][2], const float* b16, const float mul = 1.0f) {
    f32x4 t[4];
#pragma unroll
    for (int q = 0; q < 4; ++q) t[q] = *(const f32x4*)(b16 + 4 * q) * mul;
#pragma unroll
    for (int a = 0; a < 2; ++a)
#pragma unroll
        for (int b = 0; b < 2; ++b)
#pragma unroll
            for (int m = 0; m < 4; ++m)
#pragma unroll
                for (int n = 0; n < 2; ++n)
#pragma unroll
                    for (int i = 0; i < 4; ++i) acc[a][b][m >> 1][((m & 1) * 2 + n) * 4 + i] = t[2 * b + n][i];
}
typedef int v8i32 __attribute__((ext_vector_type(8)));
template <bool F8, class Epi, class Sched>
__device__ __forceinline__ void gemm(LAS unsigned char* lds, const char* A, const int Kb, const Sched& S, const Epi& E) {
    const int tid = opaque_tid(), wid = __builtin_amdgcn_readfirstlane(tid >> 6), lane = tid & 63, wr = wid >> 2, wc = wid & 3, fr = lane & 15, fq = lane >> 4;
    const int nt = Kb / 128;
    unsigned voB[2][2];
#pragma unroll
    for (int i = 0; i < 2; ++i) { int R, Cb; if (F8) stage_rc_f8(tid * 16 + i * 8192, R, Cb); else { int C; stage_rc(tid * 16 + i * 8192, R, C); Cb = C * 2; }
#pragma unroll
        for (int h = 0; h < 2; ++h) voB[h][i] = (unsigned)(Epi::bcolmap(h, R) * Kb + Cb); }
    const unsigned ldsw = (unsigned)wid * 1024u;
    const int aoff0 = lds_byte(wr * 64 + fr, fq * 8), aoff1 = aoff0 + 1024;
    const int boff0 = lds_byte(wc * 32 + fr, fq * 8), boff1 = boff0 + 1024;
#define GX_SA(b, h) (((b) * 2 + (h)) * HTB)
#define GX_SB(b, h) ((4 + (b) * 2 + (h)) * HTB)
#define GX_STAGE(bufoff, rsrc, soff, voff) do { _Pragma("unroll") for (int _i = 0; _i < 2; ++_i) \
        __builtin_amdgcn_raw_ptr_buffer_load_lds(rsrc, (LAS unsigned*)(lds + (bufoff) + ldsw + _i * 8192), 16, (int)(voff)[_i], (int)(soff), 0, 0); } while (0)
#define GX_LDA(dst, b, h) do { _Pragma("unroll") for (int m = 0; m < 4; ++m) { dst[m][0] = *(const LAS u32x4*)(lds + GX_SA(b, h) + aoff0 + m * 2048); dst[m][1] = *(const LAS u32x4*)(lds + GX_SA(b, h) + aoff1 + m * 2048); } } while (0)
#define GX_LDB(dst, b, h) do { _Pragma("unroll") for (int n = 0; n < 2; ++n) { dst[n][0] = *(const LAS u32x4*)(lds + GX_SB(b, h) + boff0 + n * 2048); dst[n][1] = *(const LAS u32x4*)(lds + GX_SB(b, h) + boff1 + n * 2048); } } while (0)
#define GX_MMA(ai, bj, At, Bt) do { __builtin_amdgcn_s_setprio(1); _Pragma("unroll") for (int m = 0; m < 4; ++m) _Pragma("unroll") for (int n = 0; n < 2; ++n) { \
        f32x16& _w = acc[ai][bj][m >> 1]; const int _o = ((m & 1) * 2 + n) * 4; f32x4 _c = {_w[_o], _w[_o + 1], _w[_o + 2], _w[_o + 3]}; \
        if constexpr (F8) { const v8i32 _b = {(int)Bt[n][0].x, (int)Bt[n][0].y, (int)Bt[n][0].z, (int)Bt[n][0].w, (int)Bt[n][1].x, (int)Bt[n][1].y, (int)Bt[n][1].z, (int)Bt[n][1].w}; \
            const v8i32 _a = {(int)At[m][0].x, (int)At[m][0].y, (int)At[m][0].z, (int)At[m][0].w, (int)At[m][1].x, (int)At[m][1].y, (int)At[m][1].z, (int)At[m][1].w}; \
            _c = __builtin_amdgcn_mfma_scale_f32_16x16x128_f8f6f4(_b, _a, _c, 0, 0, 0, 0x7f7f7f7f, 0, 0x7f7f7f7f); } \
        else { _Pragma("unroll") for (int k = 0; k < 2; ++k) _c = __builtin_amdgcn_mfma_f32_16x16x32_bf16(__builtin_bit_cast(bf16x8, Bt[n][k]), __builtin_bit_cast(bf16x8, At[m][k]), _c, 0, 0, 0); } \
        _w[_o] = _c[0]; _w[_o + 1] = _c[1]; _w[_o + 2] = _c[2]; _w[_o + 3] = _c[3]; } \
        __builtin_amdgcn_s_setprio(0); } while (0)
#define GX_WAIT_V(n) asm volatile("s_waitcnt vmcnt(" #n ")" ::: "memory")
#define GX_WAIT_L(n) asm volatile("s_waitcnt lgkmcnt(" #n ")" ::: "memory")
#define GX_BAR __builtin_amdgcn_s_barrier()
#define GX_SCHED __builtin_amdgcn_sched_barrier(0)
    Unit cur, nxt; int ui = 0;
    if (!S.next(0, cur)) return;
    u32x4 At[4][2], B0[2][2], B1[2][2];
    unsigned voC[2][2];
    S.finish(cur, 0, voC, tid);
    asm volatile("" : "+v"(voC[0][0]), "+v"(voC[0][1]), "+v"(voC[1][0]), "+v"(voC[1][1]));
    f32x16 acc[2][2][2];
    E.init(acc, cur, wc, fq);
    unsigned cB = cur.B;
    const __amdgpu_buffer_rsrc_t rA = __builtin_amdgcn_make_buffer_rsrc((void*)A, 0, -1, 0x00020000);
    const __amdgpu_buffer_rsrc_t rB = __builtin_amdgcn_make_buffer_rsrc((void*)S.wbase(), 0, -1, 0x00020000);
    GX_STAGE(GX_SB(0, 0), rB, cB, voB[0]); GX_STAGE(GX_SB(0, 1), rB, cB, voB[1]); GX_STAGE(GX_SA(0, 0), rA, 0, voC[0]); GX_STAGE(GX_SA(0, 1), rA, 0, voC[1]);
    if (wr == 1) GX_BAR;
    GX_WAIT_V(2); GX_BAR;
    GX_STAGE(GX_SB(1, 0), rB, cB + 128, voB[0]); GX_STAGE(GX_SA(1, 0), rA, 128, voC[0]); GX_STAGE(GX_SB(1, 1), rB, cB + 128, voB[1]);
    GX_WAIT_V(6); GX_BAR;
#define GX_KITER(a1, a2, b2, OA, O1) do { \
              \
            GX_LDB(B0, 0, 0); GX_LDB(B1, 0, 1); GX_SCHED; GX_LDA(At, 0, 0); GX_STAGE(GX_SA(1, 1), rA, a1, O1); \
            GX_WAIT_V(8); GX_WAIT_L(0); GX_BAR; GX_MMA(0, 0, At, B0); GX_MMA(0, 1, At, B1); GX_BAR; GX_SCHED; \
              \
            GX_LDA(At, 0, 1); GX_STAGE(GX_SB(0, 0), rB, b2, voB[0]); GX_STAGE(GX_SB(0, 1), rB, b2, voB[1]); GX_STAGE(GX_SA(0, 0), rA, a2, OA[0]); \
            GX_WAIT_V(8); GX_WAIT_L(0); GX_BAR; GX_MMA(1, 0, At, B0); GX_MMA(1, 1, At, B1); GX_BAR; GX_SCHED; \
              \
            GX_LDB(B0, 1, 0); GX_LDB(B1, 1, 1); GX_SCHED; GX_LDA(At, 1, 0); GX_STAGE(GX_SA(0, 1), rA, a2, OA[1]); \
            GX_WAIT_V(8); GX_WAIT_L(0); GX_BAR; GX_MMA(0, 0, At, B0); GX_MMA(0, 1, At, B1); GX_BAR; GX_SCHED; \
              \
            GX_LDA(At, 1, 1); GX_STAGE(GX_SB(1, 0), rB, (b2) + 128, voB[0]); GX_STAGE(GX_SB(1, 1), rB, (b2) + 128, voB[1]); GX_STAGE(GX_SA(1, 0), rA, (a2) + 128, OA[0]); \
            GX_WAIT_V(8); GX_WAIT_L(0); GX_BAR; GX_MMA(1, 0, At, B0); GX_MMA(1, 1, At, B1); GX_BAR; GX_SCHED; } while (0)
    for (;;) {
        const bool has_next = S.next(ui + 1, nxt);
        unsigned nB = cB;
        asm volatile(".p2align 6" ::: "memory");
#pragma unroll 1
        for (int t = 0; t < nt; t += 2) {
            const bool last = (t == nt - 2);
            unsigned o1[2] = {voC[1][0], voC[1][1]};
            if (last && has_next) {
                asm volatile("" ::: "memory");
                S.finish(nxt, ui + 1, voC, tid); nB = nxt.B;
                asm volatile("" : "+v"(voC[0][0]), "+v"(voC[0][1]), "+v"(voC[1][0]), "+v"(voC[1][1]));
            }
            if (t == 2) E.prefetch(cur, wid, lane);
            const unsigned a1 = (unsigned)(t + 1) * 128u;
            const unsigned a2 = last ? 0u : (unsigned)(t + 2) * 128u;
            const unsigned b2 = last ? nB : cB + (unsigned)(t + 2) * 128u;
            GX_KITER(a1, a2, b2, voC, o1);
        }
        if (wr == 0) GX_BAR;
        E(acc, cur, wr, wc, fr, fq);
        if (!has_next) break;
        E.init(acc, nxt, wc, fq);
        cur = nxt; cB = nB; ++ui;
        if (wr == 1) GX_BAR;
    }
    GX_WAIT_V(0);
    GX_BAR;
#undef GX_KITER
#undef GX_SA
#undef GX_SB
#undef GX_STAGE
#undef GX_LDA
#undef GX_LDB
#undef GX_MMA
#undef GX_WAIT_V
#undef GX_WAIT_L
#undef GX_BAR
#undef GX_SCHED
}

#define GX_V16(v, ai, m) float v[16]; _Pragma("unroll") for (int bj = 0; bj < 2; ++bj) _Pragma("unroll") for (int n = 0; n < 2; ++n) _Pragma("unroll") for (int i = 0; i < 4; ++i) v[8 * bj + 4 * n + i] = acc[ai][bj][(m) >> 1][(((m) & 1) * 2 + n) * 4 + i];
__device__ __forceinline__ void store16_bf16(bf16* dst, const float (&v)[16]) {
    u32x4 w0, w1;
    w0.x = cvt_pk(v[0], v[1]); w0.y = cvt_pk(v[2], v[3]); w0.z = cvt_pk(v[4], v[5]); w0.w = cvt_pk(v[6], v[7]);
    w1.x = cvt_pk(v[8], v[9]); w1.y = cvt_pk(v[10], v[11]); w1.z = cvt_pk(v[12], v[13]); w1.w = cvt_pk(v[14], v[15]);
    *(u32x4*)dst = w0; *(u32x4*)(dst + 8) = w1;
}
struct EpiU {
    bf16* U; const float* bias; const float* rope; LAS unsigned char* aux;
    static __device__ __forceinline__ int bcolmap(int h, int R) { return 64 * (R >> 5) + 32 * h + 8 * ((R >> 2) & 3) + 4 * ((R >> 4) & 1) + (R & 3); }
    __device__ __forceinline__ void init(f32x16 (&acc)[2][2][2], const Unit&, int, int) const { acc_zero(acc); }
    __device__ __forceinline__ void prefetch(const Unit& u, int wid, int lane) const {
        if (wid == 0) { const __amdgpu_buffer_rsrc_t r = __builtin_amdgcn_make_buffer_rsrc((void*)bias, 0, -1, 0x00020000);
            __builtin_amdgcn_raw_ptr_buffer_load_lds(r, (LAS unsigned*)aux, 16, lane * 16, u.pn * 256 * 4, 0, 0); }
    }
    __device__ __forceinline__ void operator()(const f32x16 (&acc)[2][2][2], const Unit& u, int wr, int wc, int fr, int fq) const {
        asm volatile("" : "+v"(fr), "+v"(fq));
        const int cA = 64 * wc + 8 * fq, col0 = u.pn * 256 + cA;
        const bool do_rope = u.pn < 4; const float sc = (u.pn >= 2) ? 0.08838834764831845f : 1.0f;
        const int j0 = (col0 & 127) >> 1, row00 = u.pm * 256 + wr * 64 + fr;
        float bv[16];
#pragma unroll
        for (int q = 0; q < 4; ++q) { const f32x4 t = *(const LAS f32x4*)(aux + (cA + 32 * (q >> 1) + 4 * (q & 1)) * 4); bv[4 * q] = t[0]; bv[4 * q + 1] = t[1]; bv[4 * q + 2] = t[2]; bv[4 * q + 3] = t[3]; }
        f32x4 nx[4];
        if (do_rope) { const f32x4* cs = (const f32x4*)(rope + ((size_t)row00 * 64 + j0) * 2);
#pragma unroll
            for (int q = 0; q < 4; ++q) nx[q] = cs[(q >> 1) * 8 + (q & 1)]; }
#pragma unroll
        for (int gi = 0; gi < 8; ++gi) {
            const int ai = gi >> 2, m = gi & 3, row = row00 + ai * 128 + m * 16;
            GX_V16(v, ai, m)
#pragma unroll
            for (int q = 0; q < 16; ++q) v[q] += bv[q];
            if (do_rope) {
                f32x4 cx[4];
#pragma unroll
                for (int q = 0; q < 4; ++q) cx[q] = nx[q];
                if (gi < 7) { const int rown = row00 + ((gi + 1) >> 2) * 128 + ((gi + 1) & 3) * 16; const f32x4* cs = (const f32x4*)(rope + ((size_t)rown * 64 + j0) * 2);
#pragma unroll
                    for (int q = 0; q < 4; ++q) nx[q] = cs[(q >> 1) * 8 + (q & 1)]; }
#pragma unroll
                for (int q = 0; q < 4; ++q) { const f32x4 t = cx[q];
                    const float a0 = v[4 * q], a1 = v[4 * q + 1], b0 = v[4 * q + 2], b1 = v[4 * q + 3];
                    v[4 * q] = (a0 * t[0] - a1 * t[1]) * sc; v[4 * q + 1] = (a0 * t[1] + a1 * t[0]) * sc;
                    v[4 * q + 2] = (b0 * t[2] - b1 * t[3]) * sc; v[4 * q + 3] = (b0 * t[3] + b1 * t[2]) * sc; }
            }
            { bf16* dst = U + (size_t)row * INW + col0; u32x4 w0, w1;
              w0.x = cvt_pk(v[0], v[1]); w0.y = cvt_pk(v[2], v[3]); w0.z = cvt_pk(v[4], v[5]); w0.w = cvt_pk(v[6], v[7]); w1.x = cvt_pk(v[8], v[9]); w1.y = cvt_pk(v[10], v[11]); w1.z = cvt_pk(v[12], v[13]); w1.w = cvt_pk(v[14], v[15]);
              *(u32x4*)dst = w0; *(u32x4*)(dst + 32) = w1; }
            asm volatile("" ::: "memory");
        }
    }
};
struct EpiBf16Plain {
    bf16* O; int ldc;
    static __device__ __forceinline__ int bcolmap(int h, int R) { return bcol(h, R); }
    __device__ __forceinline__ void prefetch(const Unit&, int, int) const {}
    __device__ __forceinline__ void init(f32x16 (&acc)[2][2][2], const Unit&, int, int) const { acc_zero(acc); }
    __device__ __forceinline__ void operator()(const f32x16 (&acc)[2][2][2], const Unit& u, int wr, int wc, int fr, int fq) const {
        asm volatile("" : "+v"(fr), "+v"(fq));
        const int col0 = u.pn * 256 + 16 * (4 * wc + fq);
#pragma unroll
        for (int ai = 0; ai < 2; ++ai)
#pragma unroll
            for (int m = 0; m < 4; ++m) { const int row = u.pm * 256 + ai * 128 + wr * 64 + m * 16 + fr; GX_V16(v, ai, m) store16_bf16(O + (size_t)row * ldc + col0, v); asm volatile("" ::: "memory"); }
    }
};
constexpr float F8_PSCALE = 16.0f;
struct EpiF8Plain {
    unsigned char* O; int ldc;
    static __device__ __forceinline__ int bcolmap(int h, int R) { return bcol(h, R); }
    __device__ __forceinline__ void prefetch(const Unit&, int, int) const {}
    __device__ __forceinline__ void init(f32x16 (&acc)[2][2][2], const Unit&, int, int) const { acc_zero(acc); }
    __device__ __forceinline__ void operator()(const f32x16 (&acc)[2][2][2], const Unit& u, int wr, int wc, int fr, int fq) const {
        asm volatile("" : "+v"(fr), "+v"(fq));
        const int col0 = u.pn * 256 + 16 * (4 * wc + fq);
#pragma unroll
        for (int ai = 0; ai < 2; ++ai)
#pragma unroll
            for (int m = 0; m < 4; ++m) { const int row = u.pm * 256 + ai * 128 + wr * 64 + m * 16 + fr; GX_V16(v, ai, m)
#pragma unroll
                for (int i = 0; i < 16; ++i) v[i] *= F8_PSCALE;
                u32x4 w8; w8.x = pk4_fp8(v[0], v[1], v[2], v[3]); w8.y = pk4_fp8(v[4], v[5], v[6], v[7]); w8.z = pk4_fp8(v[8], v[9], v[10], v[11]); w8.w = pk4_fp8(v[12], v[13], v[14], v[15]);
                *(u32x4*)(O + (size_t)row * ldc + col0) = w8; asm volatile("" ::: "memory"); }
    }
};
struct EpiRouter {
    const float* x; bf16* H1B; unsigned char* H1F8; const bf16* WRB; float* RP; LAS unsigned char* tab;
    static __device__ __forceinline__ int bcolmap(int h, int R) { return bcol(h, R); }
    __device__ __forceinline__ void prefetch(const Unit&, int, int) const {}
    __device__ __forceinline__ void init(f32x16 (&acc)[2][2][2], const Unit&, int, int) const { acc_zero(acc); }
    __device__ __forceinline__ void operator()(const f32x16 (&acc)[2][2][2], const Unit& u, int wr, int wc, int fr, int fq) const {
        asm volatile("" : "+v"(fr), "+v"(fq));
        const int col0 = u.pn * 256 + 16 * (4 * wc + fq), row00 = u.pm * 256 + wr * 64;
        const bf16* wb = WRB + fr * 1024 + col0;
        const size_t qbase = (size_t)u.pn * (NTOK / 16);
        LAS float* mine = (LAS float*)tab + (wr * 4 + wc) * 528; const LAS float* quad = (const LAS float*)tab + wr * 4 * 528;
        const int lane_ = fq * 16 + fr;
        bf16x8 bh[2][2], bl[2][2];
#pragma unroll
        for (int et = 0; et < 2; ++et)
#pragma unroll
            for (int s2 = 0; s2 < 2; ++s2) { bh[et][s2] = *(const bf16x8*)(wb + et * 16 * 1024 + 8 * s2); bl[et][s2] = *(const bf16x8*)(wb + 32 * 1024 + et * 16 * 1024 + 8 * s2); }
        f32x4 nx[4];
        { const float* xp = x + (size_t)(row00 + fr) * DM + col0;
#pragma unroll
          for (int q = 0; q < 4; ++q) nx[q] = *(const f32x4*)(xp + 4 * q); }
#pragma unroll
        for (int gi = 0; gi < 8; ++gi) {
            const int ai = gi >> 2, m = gi & 3, rowb = row00 + ai * 128 + m * 16, row = rowb + fr;
            const size_t off = (size_t)row * DM + col0; GX_V16(v, ai, m)
            f32x4 cx[4];
#pragma unroll
            for (int q = 0; q < 4; ++q) cx[q] = nx[q];
            if (gi < 7) { const float* xp = x + (size_t)(row00 + ((gi + 1) >> 2) * 128 + ((gi + 1) & 3) * 16 + fr) * DM + col0;
#pragma unroll
                for (int q = 0; q < 4; ++q) nx[q] = *(const f32x4*)(xp + 4 * q); }
#pragma unroll
            for (int q = 0; q < 4; ++q) { v[4 * q] += cx[q][0]; v[4 * q + 1] += cx[q][1]; v[4 * q + 2] += cx[q][2]; v[4 * q + 3] += cx[q][3]; }
            unsigned hp[8], lp[8]; float ss = 0.f;
#pragma unroll
            for (int q = 0; q < 8; ++q) { hp[q] = cvt_pk(v[2 * q], v[2 * q + 1]); lp[q] = cvt_pk(v[2 * q] - bflo(hp[q]), v[2 * q + 1] - bfhi(hp[q])); ss += v[2 * q] * v[2 * q] + v[2 * q + 1] * v[2 * q + 1]; }
            { u32x4 w8; w8.x = pk4_fp8(v[0] * F8_ASCALE, v[1] * F8_ASCALE, v[2] * F8_ASCALE, v[3] * F8_ASCALE); w8.y = pk4_fp8(v[4] * F8_ASCALE, v[5] * F8_ASCALE, v[6] * F8_ASCALE, v[7] * F8_ASCALE);
              w8.z = pk4_fp8(v[8] * F8_ASCALE, v[9] * F8_ASCALE, v[10] * F8_ASCALE, v[11] * F8_ASCALE); w8.w = pk4_fp8(v[12] * F8_ASCALE, v[13] * F8_ASCALE, v[14] * F8_ASCALE, v[15] * F8_ASCALE);
              *(u32x4*)(H1F8 + off) = w8; }
            ss += __shfl_xor(ss, 16); ss += __shfl_xor(ss, 32);
            const bf16x8 ah0 = __builtin_bit_cast(bf16x8, (u32x4){hp[0], hp[1], hp[2], hp[3]}), ah1 = __builtin_bit_cast(bf16x8, (u32x4){hp[4], hp[5], hp[6], hp[7]});
            const bf16x8 al0 = __builtin_bit_cast(bf16x8, (u32x4){lp[0], lp[1], lp[2], lp[3]}), al1 = __builtin_bit_cast(bf16x8, (u32x4){lp[4], lp[5], lp[6], lp[7]});
            float* rp = RP + (qbase + (rowb >> 4)) * 528;
#pragma unroll
            for (int et = 0; et < 2; ++et) {
                f32x4 d = (f32x4){0.f, 0.f, 0.f, 0.f};
                d = __builtin_amdgcn_mfma_f32_16x16x32_bf16(ah0, bh[et][0], d, 0, 0, 0); d = __builtin_amdgcn_mfma_f32_16x16x32_bf16(ah1, bh[et][1], d, 0, 0, 0);
                d = __builtin_amdgcn_mfma_f32_16x16x32_bf16(al0, bh[et][0], d, 0, 0, 0); d = __builtin_amdgcn_mfma_f32_16x16x32_bf16(al1, bh[et][1], d, 0, 0, 0);
                d = __builtin_amdgcn_mfma_f32_16x16x32_bf16(ah0, bl[et][0], d, 0, 0, 0); d = __builtin_amdgcn_mfma_f32_16x16x32_bf16(ah1, bl[et][1], d, 0, 0, 0);
                *(LAS f32x4*)(mine + et * 256 + fr * 16 + fq * 4) = d;
            }
            if (fq == 0) mine[512 + fr] = ss;
            asm volatile("s_waitcnt lgkmcnt(0)" ::: "memory"); __builtin_amdgcn_s_barrier(); asm volatile("" ::: "memory");
            if (lane_ < 33) { const int j = 33 * wc + lane_;
                const f32x4 t = ((*(const LAS f32x4*)(quad + 4 * j) + *(const LAS f32x4*)(quad + 528 + 4 * j)) + *(const LAS f32x4*)(quad + 2 * 528 + 4 * j)) + *(const LAS f32x4*)(quad + 3 * 528 + 4 * j);
                *(f32x4*)(rp + 4 * j) = t; }
            asm volatile("s_waitcnt lgkmcnt(0)" ::: "memory"); __builtin_amdgcn_s_barrier(); asm volatile("" ::: "memory");
        }
    }
};
__device__ __forceinline__ int bcol_up(int h, int R) { const int L = 4 * (R >> 5) + ((R >> 2) & 3), n = (R >> 4) & 1, i = R & 3; return 16 * L + 2 * (2 * (2 * h + n) + (i & 1)) + (i >> 1); }
struct EpiUp {
    unsigned char* ACT; const float* bupp; const float* rowscale; LAS unsigned char* aux;
    static __device__ __forceinline__ int bcolmap(int h, int R) { return bcol_up(h, R); }
    __device__ __forceinline__ void init(f32x16 (&acc)[2][2][2], const Unit&, int, int) const { acc_zero(acc); }
    __device__ __forceinline__ void prefetch(const Unit& u, int wid, int lane) const {
        if (wid == 0) { const __amdgpu_buffer_rsrc_t r = __builtin_amdgcn_make_buffer_rsrc((void*)bupp, 0, -1, 0x00020000);
            __builtin_amdgcn_raw_ptr_buffer_load_lds(r, (LAS unsigned*)aux, 16, lane * 16, (int)(((size_t)u.e * UPW + u.pn * 256) * 4), 0, 0); }
        if (wid == 1) { const __amdgpu_buffer_rsrc_t r = __builtin_amdgcn_make_buffer_rsrc((void*)rowscale, 0, -1, 0x00020000);
            __builtin_amdgcn_raw_ptr_buffer_load_lds(r, (LAS unsigned*)(aux + 1024), 16, lane * 16, u.pm * 256 * 4, 0, 0); }
    }
    __device__ __forceinline__ void operator()(const f32x16 (&acc)[2][2][2], const Unit& u, int wr, int wc, int fr, int fq) const {
        asm volatile("" : "+v"(fr), "+v"(fq));
        const int c16 = 16 * (4 * wc + fq), col0 = u.pn * 256 + c16;
        f32x4 bq[4]; f32x2 bl8[4];
#pragma unroll
        for (int q = 0; q < 4; ++q) { bq[q] = *(const LAS f32x4*)(aux + (c16 + 4 * q) * 4); bl8[q] = (f32x2){bq[q][2] * F8_ASCALE + F8_ASCALE, bq[q][3] * F8_ASCALE + F8_ASCALE}; }
        float rsv[8];
#pragma unroll
        for (int gi = 0; gi < 8; ++gi) rsv[gi] = *(const LAS float*)(aux + 1024 + ((gi >> 2) * 128 + wr * 64 + (gi & 3) * 16 + fr) * 4);
#pragma unroll
        for (int ai = 0; ai < 2; ++ai)
#pragma unroll
            for (int m = 0; m < 4; ++m) { const int row = u.pm * 256 + ai * 128 + wr * 64 + m * 16 + fr; const float rs = rsv[ai * 4 + m], rs8 = rs * F8_ASCALE;
                f32x2 o[4];
#pragma unroll
                for (int q = 0; q < 4; ++q) { const int bj = q >> 1, n = q & 1; const f32x16& w16 = acc[ai][bj][m >> 1]; const int ob = ((m & 1) * 2 + n) * 4;
                    f32x2 G = {w16[ob], w16[ob + 1]}, Lv = {w16[ob + 2], w16[ob + 3]};
                    G = G * rs + (f32x2){bq[q][0], bq[q][1]}; Lv = Lv * rs8 + (f32x2){bl8[q][0], bl8[q][1]};
                    G[0] = fminf(G[0], 7.0f); G[1] = fminf(G[1], 7.0f); Lv[0] = fminf(fmaxf(Lv[0], -6.0f * F8_ASCALE), 8.0f * F8_ASCALE); Lv[1] = fminf(fmaxf(Lv[1], -6.0f * F8_ASCALE), 8.0f * F8_ASCALE);
                    const f32x2 z = G * (-1.702f * 1.4426950408889634f);
                    f32x2 d = {__builtin_amdgcn_exp2f(z[0]), __builtin_amdgcn_exp2f(z[1])}; d = d + 1.0f;
                    const f32x2 sg = {__builtin_amdgcn_rcpf(d[0]), __builtin_amdgcn_rcpf(d[1])};
                    o[q] = (G * sg) * Lv; }
                u32x2 w; w.x = pk4_fp8(o[0][0], o[0][1], o[1][0], o[1][1]); w.y = pk4_fp8(o[2][0], o[2][1], o[3][0], o[3][1]);
                *(u32x2*)(ACT + (size_t)row * DFF + (col0 >> 1)) = w; asm volatile("" ::: "memory"); }
    }
};
constexpr float F8_YSCALE = 16.0f;
struct EpiDown {
    unsigned char* Y; const float* b_dn; const int* rowslot; LAS unsigned char* aux;
    static __device__ __forceinline__ int bcolmap(int h, int R) { return bcol(h, R); }
    __device__ __forceinline__ void init(f32x16 (&acc)[2][2][2], const Unit&, int, int) const { acc_zero(acc); }
    __device__ __forceinline__ void prefetch(const Unit& u, int wid, int lane) const {
        if (wid == 0) { const __amdgpu_buffer_rsrc_t r = __builtin_amdgcn_make_buffer_rsrc((void*)b_dn, 0, -1, 0x00020000);
            __builtin_amdgcn_raw_ptr_buffer_load_lds(r, (LAS unsigned*)aux, 16, lane * 16, (int)(((size_t)u.e * DM + u.pn * 256) * 4), 0, 0); }
        if (wid == 1) { const __amdgpu_buffer_rsrc_t r = __builtin_amdgcn_make_buffer_rsrc((void*)rowslot, 0, -1, 0x00020000);
            __builtin_amdgcn_raw_ptr_buffer_load_lds(r, (LAS unsigned*)(aux + 1024), 16, lane * 16, u.pm * 256 * 4, 0, 0); }
    }
    __device__ __forceinline__ void operator()(const f32x16 (&acc)[2][2][2], const Unit& u, int wr, int wc, int fr, int fq) const {
        asm volatile("" : "+v"(fr), "+v"(fq));
        const int c16 = 16 * (4 * wc + fq), col0 = u.pn * 256 + c16;
        float bv[16];
#pragma unroll
        for (int q = 0; q < 4; ++q) { const f32x4 t = *(const LAS f32x4*)(aux + (c16 + 4 * q) * 4); bv[4 * q] = t[0]; bv[4 * q + 1] = t[1]; bv[4 * q + 2] = t[2]; bv[4 * q + 3] = t[3]; }
        int slv[8];
#pragma unroll
        for (int gi = 0; gi < 8; ++gi) slv[gi] = *(const LAS int*)(aux + 1024 + ((gi >> 2) * 128 + wr * 64 + (gi & 3) * 16 + fr) * 4);
#pragma unroll
        for (int ai = 0; ai < 2; ++ai)
#pragma unroll
            for (int m = 0; m < 4; ++m) { const int slot = slv[ai * 4 + m]; GX_V16(v, ai, m)
#pragma unroll
                for (int i = 0; i < 16; ++i) v[i] = v[i] * (F8_YSCALE / (F8_WSCALE * F8_ASCALE)) + bv[i] * F8_YSCALE;
                if (slot >= 0) { u32x4 w8; w8.x = pk4_fp8(v[0], v[1], v[2], v[3]); w8.y = pk4_fp8(v[4], v[5], v[6], v[7]); w8.z = pk4_fp8(v[8], v[9], v[10], v[11]); w8.w = pk4_fp8(v[12], v[13], v[14], v[15]);
                    *(u32x4*)(Y + (size_t)slot * DM + col0) = w8; }
                asm volatile("" ::: "memory"); }
    }
};
struct EpiGate {
    const unsigned char* PJ; unsigned char* T; float ascale;
    static __device__ __forceinline__ int bcolmap(int h, int R) { return bcol(h, R); }
    __device__ __forceinline__ void init(f32x16 (&acc)[2][2][2], const Unit&, int, int) const { acc_zero(acc); }
    __device__ __forceinline__ void prefetch(const Unit&, int, int) const {}
    __device__ __forceinline__ void operator()(const f32x16 (&acc)[2][2][2], const Unit& u, int wr, int wc, int fr, int fq) const {
        asm volatile("" : "+v"(fr), "+v"(fq));
        const int col0 = u.pn * 256 + 16 * (4 * wc + fq), row00 = u.pm * 256 + wr * 64 + fr;
        u32x4 pq[8];
#pragma unroll
        for (int gi = 0; gi < 8; ++gi) pq[gi] = *(const u32x4*)(PJ + (size_t)(row00 + (gi >> 2) * 128 + (gi & 3) * 16) * DM + col0);
#pragma unroll
        for (int gi = 0; gi < 8; ++gi) {
            const int ai = gi >> 2, m = gi & 3; const size_t off = (size_t)(row00 + ai * 128 + m * 16) * DM + col0; GX_V16(v, ai, m)
            const unsigned pw[4] = {pq[gi].x, pq[gi].y, pq[gi].z, pq[gi].w};
#pragma unroll
            for (int q = 0; q < 4; ++q) { const f32x2 lo = __builtin_amdgcn_cvt_pk_f32_fp8((int)pw[q], false), hi = __builtin_amdgcn_cvt_pk_f32_fp8((int)pw[q], true);
                v[4 * q] = sigmoidf_(v[4 * q] * ascale) * lo[0]; v[4 * q + 1] = sigmoidf_(v[4 * q + 1] * ascale) * lo[1];
                v[4 * q + 2] = sigmoidf_(v[4 * q + 2] * ascale) * hi[0]; v[4 * q + 3] = sigmoidf_(v[4 * q + 3] * ascale) * hi[1]; }
            u32x4 w8; w8.x = pk4_fp8(v[0], v[1], v[2], v[3]); w8.y = pk4_fp8(v[4], v[5], v[6], v[7]); w8.z = pk4_fp8(v[8], v[9], v[10], v[11]); w8.w = pk4_fp8(v[12], v[13], v[14], v[15]);
            *(u32x4*)(T + off) = w8; asm volatile("" ::: "memory"); }
    }
};
}

struct Args {
    const float* x; const float* p; const int* positions; const float* rel_bias; const float* g_mix; const float* w_in; const float* b_in;
    const float* ret_g; const float* sinks; const float* w_out; const float* g_moe; const float* w_router; const float* b_router;
    const float* w_up; const float* b_up; const float* w_down; const float* b_down; const float* w_gate; const float* w_proj;
    const float* g_ple; const float* g_final;
    float* out; unsigned char* ws;
    float inv[64];
    unsigned char bucket[128];
    int ph_lo, ph_hi;
};

struct Frame {
    LAS unsigned char* lds; int tid, lane, wave, wg, G;
};

template <bool PERM, bool KSCALE>
__device__ __forceinline__ void p0_transpose_item(const float* W, int K, int N, bf16* WT, LAS float* scr, int item, int lane, const float* kscale) {
    const int nblk = N / 32, kb = item / nblk, nb = item % nblk, k0 = 64 * kb, n0 = 32 * nb;
    float wv[32];
#pragma unroll
    for (int i = 0; i < 32; ++i) { const int kk = 2 * i + (lane >> 5); wv[i] = __builtin_nontemporal_load(W + (size_t)(k0 + kk) * N + n0 + (lane & 31)); }
#pragma unroll
    for (int i = 0; i < 32; ++i) { const int kk = 2 * i + (lane >> 5); float w = wv[i]; if (KSCALE) w *= kscale[k0 + kk]; scr[kk * 33 + (lane & 31)] = w; }
    LDS_WAIT(); asm volatile("" ::: "memory");
    const int c = lane & 7;
#pragma unroll
    for (int j = 0; j < 4; ++j) { const int n = (lane >> 3) + 8 * j; const LAS float* s = scr + (8 * c) * 33 + n;
        u32x4 o; o.x = pk2(s[0 * 33], s[1 * 33]); o.y = pk2(s[2 * 33], s[3 * 33]); o.z = pk2(s[4 * 33], s[5 * 33]); o.w = pk2(s[6 * 33], s[7 * 33]);
        int dn = n0 + n;
        if (PERM && dn < 1024) { const int d = dn & 127; dn = (dn - d) + 2 * (d & 63) + (d >> 6); }
        *(GAS u32x4*)(WT + (size_t)dn * K + k0 + 8 * c) = o; }
    LDS_WAIT(); asm volatile("" ::: "memory");
}
template <bool KSCALE>
__device__ __forceinline__ void p0_transpose_item_f8(const float* W, int K, int N, unsigned char* WT, LAS float* scr, int item, int lane, const float* kscale) {
    const int nblk = N / 32, kb = item / nblk, nb = item % nblk, k0 = 64 * kb, n0 = 32 * nb;
    float wv[32];
#pragma unroll
    for (int i = 0; i < 32; ++i) { const int kk = 2 * i + (lane >> 5); wv[i] = __builtin_nontemporal_load(W + (size_t)(k0 + kk) * N + n0 + (lane & 31)); }
#pragma unroll
    for (int i = 0; i < 32; ++i) { const int kk = 2 * i + (lane >> 5); float w = wv[i] * F8_WSCALE; if (KSCALE) w *= kscale[k0 + kk]; scr[kk * 33 + (lane & 31)] = w; }
    LDS_WAIT(); asm volatile("" ::: "memory");
    const int n = lane >> 1, kh = (lane & 1) * 32; const LAS float* sp = scr + kh * 33 + n;
    u32x4 o0, o1;
    o0.x = pk4_fp8(sp[0 * 33], sp[1 * 33], sp[2 * 33], sp[3 * 33]); o0.y = pk4_fp8(sp[4 * 33], sp[5 * 33], sp[6 * 33], sp[7 * 33]); o0.z = pk4_fp8(sp[8 * 33], sp[9 * 33], sp[10 * 33], sp[11 * 33]); o0.w = pk4_fp8(sp[12 * 33], sp[13 * 33], sp[14 * 33], sp[15 * 33]);
    o1.x = pk4_fp8(sp[16 * 33], sp[17 * 33], sp[18 * 33], sp[19 * 33]); o1.y = pk4_fp8(sp[20 * 33], sp[21 * 33], sp[22 * 33], sp[23 * 33]); o1.z = pk4_fp8(sp[24 * 33], sp[25 * 33], sp[26 * 33], sp[27 * 33]); o1.w = pk4_fp8(sp[28 * 33], sp[29 * 33], sp[30 * 33], sp[31 * 33]);
    unsigned char* dst = WT + (size_t)(n0 + n) * K + k0 + kh;
    *(GAS u32x4*)dst = o0; *(GAS u32x4*)(dst + 16) = o1;
    LDS_WAIT(); asm volatile("" ::: "memory");
}
template <bool KSCALE>
__device__ __forceinline__ void p0_transpose_item_f8d(const float* W, int K, int N, unsigned char* WT, LAS float* scr, int item, int lane, const float* kscale) {
    const int nblk = N / 32, kb = item / nblk, nb = item % nblk, k0 = 128 * kb, n0 = 32 * nb;
    float wv[64];
#pragma unroll
    for (int i = 0; i < 64; ++i) { const int kk = 2 * i + (lane >> 5); wv[i] = __builtin_nontemporal_load(W + (size_t)(k0 + kk) * N + n0 + (lane & 31)); }
#pragma unroll
    for (int i = 0; i < 64; ++i) { const int kk = 2 * i + (lane >> 5); float w = wv[i] * F8_WSCALE; if (KSCALE) w *= kscale[k0 + kk]; scr[kk * 33 + (lane & 31)] = w; }
    LDS_WAIT(); asm volatile("" ::: "memory");
#pragma unroll
    for (int pass = 0; pass < 2; ++pass) {
        const int n = (lane >> 2) + 16 * pass, kh = (lane & 3) * 16; const LAS float* sp = scr + kh * 33 + n;
        u32x4 o0, o1;
        o0.x = pk4_fp8(sp[0 * 33], sp[1 * 33], sp[2 * 33], sp[3 * 33]); o0.y = pk4_fp8(sp[4 * 33], sp[5 * 33], sp[6 * 33], sp[7 * 33]); o0.z = pk4_fp8(sp[8 * 33], sp[9 * 33], sp[10 * 33], sp[11 * 33]); o0.w = pk4_fp8(sp[12 * 33], sp[13 * 33], sp[14 * 33], sp[15 * 33]);
        o1.x = pk4_fp8(sp[64 * 33], sp[65 * 33], sp[66 * 33], sp[67 * 33]); o1.y = pk4_fp8(sp[68 * 33], sp[69 * 33], sp[70 * 33], sp[71 * 33]); o1.z = pk4_fp8(sp[72 * 33], sp[73 * 33], sp[74 * 33], sp[75 * 33]); o1.w = pk4_fp8(sp[76 * 33], sp[77 * 33], sp[78 * 33], sp[79 * 33]);
        unsigned char* dst = WT + (size_t)(n0 + n) * K + k0 + kh;
        *(GAS u32x4*)dst = o0; *(GAS u32x4*)(dst + 64) = o1;
    }
    LDS_WAIT(); asm volatile("" ::: "memory");
}
__device__ __forceinline__ void p0b_experts(const Args& a, const Frame& F, int gwb, int ngwb) {
    unsigned char* WUP = a.ws + WS_WUP; unsigned char* WDN = a.ws + WS_WDN;
    LAS float* scr = (LAS float*)(F.lds + F.wave * 16896);
    constexpr int I_UPE = (DM / 128) * (UPW / 32), I_DNE = (DFF / 128) * (DM / 32);
    for (int it = gwb; it < NEXP * (I_UPE + I_DNE); it += ngwb) {
        int r = it;
        if (r < NEXP * I_UPE) { const int e = r / I_UPE; p0_transpose_item_f8d<true>(a.w_up + (size_t)e * DM * UPW, DM, UPW, WUP + (size_t)e * UPW * DM, scr, r % I_UPE, F.lane, a.g_moe); continue; } r -= NEXP * I_UPE;
        { const int e = r / I_DNE; p0_transpose_item_f8d<false>(a.w_down + (size_t)e * DFF * DM, DFF, DM, WDN + (size_t)e * DM * DFF, scr, r % I_DNE, F.lane, nullptr); }
    }
    __syncthreads();
}
__device__ __forceinline__ void p0_prologue(const Args& a, const Frame& F) {
    unsigned char* ws = a.ws;
    LAS float* scr = (LAS float*)(F.lds + F.wave * 16384);
    const int gw = F.wg * NWAVES + F.wave, NGW = F.G * NWAVES;
    bf16* WIN = (bf16*)(ws + WS_WIN); bf16* WOUT = (bf16*)(ws + WS_WOUT); bf16* WG = (bf16*)(ws + WS_WG); bf16* WP = (bf16*)(ws + WS_WP);
    constexpr int I_IN = (DM / 64) * (INW / 32), I_SQ = (DM / 64) * (DM / 32), I_PJ = (PLE / 64) * (DM / 32);
    constexpr int NITEMS = I_IN + 2 * I_SQ + I_PJ;
    for (int it = gw; it < NITEMS; it += NGW) {
        int r = it;
        if (r < I_IN) { p0_transpose_item<true, false>(a.w_in, DM, INW, WIN, scr, r, F.lane, nullptr); continue; } r -= I_IN;
        if (r < I_SQ) { p0_transpose_item<false, false>(a.w_out, DM, DM, WOUT, scr, r, F.lane, nullptr); continue; } r -= I_SQ;
        if (r < I_SQ) { p0_transpose_item_f8<false>(a.w_gate, DM, DM, (unsigned char*)WG, scr, r, F.lane, nullptr); continue; } r -= I_SQ;
        p0_transpose_item<false, false>(a.w_proj, PLE, DM, WP, scr, r, F.lane, nullptr);
    }
    {
        bf16* XN = (bf16*)(ws + WS_XN);
        f32x4 g[4];
#pragma unroll
        for (int j = 0; j < 4; ++j) g[j] = ((const f32x4*)a.g_mix)[F.lane + 64 * j];
        for (int m0 = gw; m0 < NTOK; m0 += 4 * NGW) {
            f32x4 v[4][4];
#pragma unroll
            for (int rr = 0; rr < 4; ++rr) { const f32x4* xr = (const f32x4*)(a.x + (size_t)(m0 + rr * NGW) * DM) + F.lane;
#pragma unroll
                for (int j = 0; j < 4; ++j) v[rr][j] = __builtin_nontemporal_load(xr + 64 * j); }
#pragma unroll
            for (int rr = 0; rr < 4; ++rr) { float s = 0.f;
#pragma unroll
                for (int j = 0; j < 4; ++j) s += (v[rr][j][0] * v[rr][j][0] + v[rr][j][1] * v[rr][j][1]) + (v[rr][j][2] * v[rr][j][2] + v[rr][j][3] * v[rr][j][3]);
                const float rstd = 1.0f / sqrtf(wave_sum(s) * (1.0f / DM) + EPS);
                u32x2* o = (u32x2*)(XN + (size_t)(m0 + rr * NGW) * DM) + F.lane;
#pragma unroll
                for (int j = 0; j < 4; ++j) { u32x2 w; w.x = pk2(v[rr][j][0] * rstd * g[j][0], v[rr][j][1] * rstd * g[j][1]); w.y = pk2(v[rr][j][2] * rstd * g[j][2], v[rr][j][3] * rstd * g[j][3]); o[64 * j] = w; } }
        }
        if (F.wg == 0) { unsigned* z = (unsigned*)(ws + WS_H1F8 + (size_t)NTOK * DM); for (int i = F.tid; i < DM / 4; i += NTHREADS) z[i] = 0u; }
    }
    const int gt = F.wg * NTHREADS + F.tid, NGT = F.G * NTHREADS;
    {
        bf16* PB = (bf16*)(ws + WS_PB);
        for (int i0 = gt; i0 < NTOK * PLE / 4; i0 += 8 * NGT) {
            f32x4 v[8];
#pragma unroll
            for (int r = 0; r < 8; ++r) v[r] = __builtin_nontemporal_load((const f32x4*)a.p + (i0 + r * NGT));
#pragma unroll
            for (int r = 0; r < 8; ++r) { u32x2 w; w.x = pk2(v[r][0], v[r][1]); w.y = pk2(v[r][2], v[r][3]); ((u32x2*)PB)[i0 + r * NGT] = w; } }
    }
    {
        f32x2* RT = (f32x2*)(ws + WS_ROPE);
        const int j = gt & 63, r0 = gt >> 6; const float invj = a.inv[j];
        int pos[16];
#pragma unroll
        for (int k = 0; k < 16; ++k) pos[k] = a.positions[r0 + k * (NGT >> 6)];
#pragma unroll
        for (int k = 0; k < 16; ++k) { const int row = r0 + k * (NGT >> 6);
            const float ang = (float)pos[k] * invj;
            double t = (double)ang * 0.15915494309189535; t -= rint(t);
            const float tf = (float)t;
            RT[(size_t)row * 64 + j] = (f32x2){__builtin_amdgcn_cosf(tf), __builtin_amdgcn_sinf(tf)}; }
    }
    { bf16* WRB = (bf16*)(ws + WS_MISC + MS_WRB);
      for (int idx = gt; idx < DM * NEXP; idx += NGT) { const int k = idx >> 5, e = idx & 31; const float v = a.g_moe[k] * a.w_router[idx];
          const unsigned hi = f2bf(v); const float rem = v - __builtin_bit_cast(float, hi << 16); WRB[e * 1024 + k] = (bf16)hi; WRB[32 * 1024 + e * 1024 + k] = (bf16)f2bf(rem); } }
    { float* BP = (float*)(ws + WS_MISC + MS_BUPP);
      for (int c = gt; c < NEXP * UPW; c += NGT) { const int grp = c & ~15, k = c & 15, quad = k >> 2, i = k & 3, p = 2 * quad + (i & 1), kind = i >> 1; BP[c] = a.b_up[grp + 2 * p + kind]; } }
    { float* BP = (float*)(ws + WS_MISC + MS_BIN);
      for (int c = gt; c < INW; c += NGT) { int dn = c; if (c < 1024) { const int d = c & 127; dn = (c - d) + 2 * (d & 63) + (d >> 6); } BP[dn] = a.b_in[c]; } }
}

typedef short v4i16_t __attribute__((ext_vector_type(4)));
__device__ __forceinline__ s16x4 ds_tr(const LAS unsigned char* p) { return __builtin_bit_cast(s16x4, __builtin_amdgcn_ds_read_tr16_b64_v4i16((LAS v4i16_t*)p)); }
__device__ __forceinline__ bf16x8 tr_frag(const LAS unsigned char* T, int stride, int krowA, int krowB, int col0, int lane) {
    const int i = lane & 15, q = i >> 2, p = i & 3;
    const s16x4 lo = ds_tr(T + (krowA + q) * stride + (col0 + 4 * p) * 2), hi = ds_tr(T + (krowB + q) * stride + (col0 + 4 * p) * 2);
    return (bf16x8){lo[0], lo[1], lo[2], lo[3], hi[0], hi[1], hi[2], hi[3]};
}
__device__ __forceinline__ bf16x8 row_frag(const LAS unsigned char* T, int stride, int row, int col) { return *(const LAS bf16x8*)(T + row * stride + col * 2); }
__device__ __forceinline__ bf16x8 pack8(const f32x4& a, const f32x4& b) {
    u32x4 w; w.x = cvt_pk(a[0], a[1]); w.y = cvt_pk(a[2], a[3]); w.z = cvt_pk(b[0], b[1]); w.w = cvt_pk(b[2], b[3]);
    return __builtin_bit_cast(bf16x8, w);
}
#define MFMA16(a, b, c) __builtin_amdgcn_mfma_f32_16x16x32_bf16((a), (b), (c), 0, 0, 0)
constexpr int TS = 272;
constexpr int TILE_B = 128 * TS;

struct TileRegs { u32x4 v[4]; };
__device__ __forceinline__ void tile_load(TileRegs& r, const bf16* src, int pitch, int tid) {
#pragma unroll
    for (int i = 0; i < 4; ++i) { const int q = tid + NTHREADS * i, row = q >> 4, c = q & 15; r.v[i] = *(const u32x4*)(src + (size_t)row * pitch + c * 8); }
}
template <int SCALE>
__device__ __forceinline__ void tile_store(LAS unsigned char* T, const TileRegs& r, int tid, float lg) {
#pragma unroll
    for (int i = 0; i < 4; ++i) { const int q = tid + NTHREADS * i, row = q >> 4, c = q & 15;
        u32x4 v = r.v[i];
        if (SCALE) { const float s = __expf((float)(SCALE == 1 ? 127 - row : (SCALE == 2 ? row : -row)) * lg);
            v.x = cvt_pk(bflo(v.x) * s, bfhi(v.x) * s); v.y = cvt_pk(bflo(v.y) * s, bfhi(v.y) * s); v.z = cvt_pk(bflo(v.z) * s, bfhi(v.z) * s); v.w = cvt_pk(bflo(v.w) * s, bfhi(v.w) * s); }
        *(LAS u32x4*)(T + row * TS + c * 16) = v; }
}

__device__ __forceinline__ void ret_kv_phase(const Args& a, const Frame& F) {
    const bf16* U = (const bf16*)(a.ws + WS_U);
    bf16* KVS = (bf16*)(a.ws + WS_KVS);
    LAS unsigned char* Kt = F.lds; LAS unsigned char* Vt = F.lds + TILE_B;
    const int lane = F.lane, g = lane >> 4, i = lane & 15, e0 = 16 * F.wave;
    constexpr int NU = NB * NCH * 4;
    TileRegs rk, rv;
    int unit = F.wg;
    if (unit < NU) { const size_t t0 = (size_t)(unit >> 2) * 128; const int h = unit & 3; tile_load(rk, U + t0 * INW + U_RK + h * 128, INW, F.tid); tile_load(rv, U + t0 * INW + U_RV + h * 128, INW, F.tid); }
    for (; unit < NU; unit += F.G) {
        const int h = unit & 3;
        const float lg = __logf(1.0f - exp2f(-5.0f - (float)h));
        tile_store<0>(Kt, rk, F.tid, 0.f); tile_store<1>(Vt, rv, F.tid, lg);
        __syncthreads();
        const int nu = unit + F.G;
        if (nu < NU) { const size_t t0 = (size_t)(nu >> 2) * 128; const int hn = nu & 3; tile_load(rk, U + t0 * INW + U_RK + hn * 128, INW, F.tid); tile_load(rv, U + t0 * INW + U_RV + hn * 128, INW, F.tid); }
        f32x4 acc[8];
#pragma unroll
        for (int et = 0; et < 8; ++et) acc[et] = (f32x4){0.f, 0.f, 0.f, 0.f};
#pragma unroll
        for (int s = 0; s < 4; ++s) {
            const int kr = 32 * s + 8 * g;
            const bf16x8 af = tr_frag(Kt, TS, kr, kr + 4, e0, lane);
#pragma unroll
            for (int et = 0; et < 8; ++et) { const bf16x8 bfr = tr_frag(Vt, TS, kr, kr + 4, 16 * et, lane); acc[et] = MFMA16(af, bfr, acc[et]); }
        }
        bf16* dst = KVS + (size_t)unit * 16384 + e0 + 4 * g;
#pragma unroll
        for (int et = 0; et < 8; ++et) { u32x2 w; w.x = cvt_pk(acc[et][0], acc[et][1]); w.y = cvt_pk(acc[et][2], acc[et][3]); *(u32x2*)(dst + (16 * et + i) * 128) = w; }
        __syncthreads();
    }
}

constexpr int AS = 144;
__device__ __forceinline__ void swa_phase(const Args& a, const Frame& F) {
    const bf16* U = (const bf16*)(a.ws + WS_U);
    bf16* MIX = (bf16*)(a.ws + WS_MIX);
    LAS unsigned char* Ks = F.lds; LAS unsigned char* Vs = F.lds + 256 * AS; LAS float* tb = (LAS float*)(F.lds + 2 * 256 * AS);
    constexpr int NU = NB * NCH * 2;
    for (int t = F.tid; t < 8 * 128; t += NTHREADS) { const int hq = t >> 7, dist = t & 127; tb[t] = a.rel_bias[(int)a.bucket[dist] * 8 + hq]; }
    const int lane = F.lane, g = lane >> 4, i = lane & 15;
    u32x4 kreg[4], vreg[4];
#define SWA_LOAD(un) do { const int hk_ = (un) & 1, bn_ = (un) >> 1, nb_ = bn_ & (NCH - 1); const size_t t0_ = (size_t)bn_ * 128; \
        _Pragma("unroll") for (int it = 0; it < 4; ++it) { const int q = F.tid + NTHREADS * it, ki = q >> 3, c = q & 7; \
            kreg[it] = (u32x4){0u, 0u, 0u, 0u}; vreg[it] = kreg[it]; \
            if (nb_ > 0 || ki >= 128) { const bf16* src = U + (t0_ - 128 + ki) * INW; kreg[it] = *(const u32x4*)(src + U_AK + hk_ * 64 + c * 8); vreg[it] = *(const u32x4*)(src + U_AV + hk_ * 64 + c * 8); } } } while (0)
    int unit = F.wg;
    if (unit < NU) SWA_LOAD(unit);
    for (; unit < NU; unit += F.G) {
        const int hk = unit & 1, bn = unit >> 1, nb = bn & (NCH - 1);
        const size_t t0 = (size_t)bn * 128;
#pragma unroll
        for (int it = 0; it < 4; ++it) { const int q = F.tid + NTHREADS * it, ki = q >> 3, c = q & 7; *(LAS u32x4*)(Ks + ki * AS + c * 16) = kreg[it]; *(LAS u32x4*)(Vs + ki * AS + c * 16) = vreg[it]; }
        __syncthreads();
        const int gq = F.wave >> 1, hq = hk * 4 + gq;
        bf16x8 qn0, qn1;
        { const int iq = 16 * ((F.wave & 1) * 4) + i; const bf16* qsrc = U + (t0 + iq) * INW + U_AQ + hq * 64 + 8 * g; qn0 = *(const bf16x8*)qsrc; qn1 = *(const bf16x8*)(qsrc + 32); }
        { const int nu = unit + F.G; if (nu < NU) SWA_LOAD(nu); }
        constexpr float L2E = 1.4426950408889634f;
        const float sink2 = a.sinks[hq] * L2E;
        float bz[9][4];
#pragma unroll
        for (int t = 0; t < 9; ++t)
#pragma unroll
            for (int r = 0; r < 4; ++r) { const int dist = 128 - 16 * t + i - 4 * g - r; bz[t][r] = (dist >= 0 && dist < 128) ? tb[hq * 128 + (dist & 127)] * L2E : -3.0e38f; }
#pragma unroll 1
        for (int it = 0; it < 4; ++it) {
            const int qg = (F.wave & 1) * 4 + it, q0 = 16 * qg, iq = q0 + i;
            const bf16x8 qf0 = qn0, qf1 = qn1;
            if (it < 3) { const bf16* qsrc = U + (t0 + iq + 16) * INW + U_AQ + hq * 64 + 8 * g; qn0 = *(const bf16x8*)qsrc; qn1 = *(const bf16x8*)(qsrc + 32); }
            f32x4 sc[10];
            float mx = sink2;
#pragma unroll
            for (int t = 0; t < 9; ++t) {
                const int krow = 16 * (qg + t) + i;
                f32x4 s = (f32x4){0.f, 0.f, 0.f, 0.f};
                s = MFMA16(row_frag(Ks, AS, krow, 8 * g), qf0, s);
                s = MFMA16(row_frag(Ks, AS, krow, 32 + 8 * g), qf1, s);
                const bool dead = (nb == 0) && (qg + t < 8);
#pragma unroll
                for (int r = 0; r < 4; ++r) { const float v = dead ? -3.0e38f : s[r] * (0.125f * L2E) + bz[t][r]; s[r] = v; mx = fmaxf(mx, v); }
                sc[t] = s;
            }
            mx = fmaxf(mx, __shfl_xor(mx, 16)); mx = fmaxf(mx, __shfl_xor(mx, 32));
            float sum = 0.f;
#pragma unroll
            for (int t = 0; t < 9; ++t)
#pragma unroll
                for (int r = 0; r < 4; ++r) { const float p = __builtin_amdgcn_exp2f(sc[t][r] - mx); sc[t][r] = p; sum += p; }
            sc[9] = (f32x4){0.f, 0.f, 0.f, 0.f};
            sum += __shfl_xor(sum, 16); sum += __shfl_xor(sum, 32);
            const float inv = 1.0f / (sum + __builtin_amdgcn_exp2f(sink2 - mx));
            f32x4 o[4];
#pragma unroll
            for (int et = 0; et < 4; ++et) o[et] = (f32x4){0.f, 0.f, 0.f, 0.f};
#pragma unroll
            for (int s2 = 0; s2 < 5; ++s2) {
                const bf16x8 pf = pack8(sc[2 * s2], sc[2 * s2 + 1]);
                const int ka = 16 * (qg + 2 * s2) + 4 * g, kb = (s2 < 4) ? ka + 16 : ka;
#pragma unroll
                for (int et = 0; et < 4; ++et) o[et] = MFMA16(tr_frag(Vs, AS, ka, kb, 16 * et, lane), pf, o[et]);
            }
            bf16* dst = MIX + (t0 + iq) * DM + 512 + hq * 64 + 4 * g;
#pragma unroll
            for (int et = 0; et < 4; ++et) { u32x2 w; w.x = cvt_pk(o[et][0] * inv, o[et][1] * inv); w.y = cvt_pk(o[et][2] * inv, o[et][3] * inv); *(u32x2*)(dst + 16 * et) = w; }
        }
        __syncthreads();
    }
#undef SWA_LOAD
}

__device__ __forceinline__ void ret_scan(const Args& a, const Frame& F) {
    const bf16* KVS = (const bf16*)(a.ws + WS_KVS);
    bf16* ST = (bf16*)(a.ws + WS_ST);
    const int gt = F.wg * NTHREADS + F.tid;
    const int b = gt >> 15, p = gt & 32767, h = p >> 13;
    const float cd = __expf(128.0f * __logf(1.0f - exp2f(-5.0f - (float)h)));
    const size_t base = (size_t)b * NCH * 65536 + 2 * (size_t)p;
    float s0 = 0.f, s1 = 0.f;
    unsigned kv[NCH];
#pragma unroll
    for (int j = 0; j < NCH; ++j) kv[j] = *(const unsigned*)(KVS + base + (size_t)j * 65536);
#pragma unroll
    for (int j = 0; j < NCH; ++j) { *(unsigned*)(ST + base + (size_t)j * 65536) = pk2(s0, s1); s0 = s0 * cd + bflo(kv[j]); s1 = s1 * cd + bfhi(kv[j]); }
}

__device__ __forceinline__ void ret_out_phase(const Args& a, const Frame& F) {
    const bf16* U = (const bf16*)(a.ws + WS_U);
    const bf16* ST = (const bf16*)(a.ws + WS_ST);
    bf16* MIX = (bf16*)(a.ws + WS_MIX);
    LAS unsigned char* Qt = F.lds; LAS unsigned char* Kt = F.lds + TILE_B; LAS unsigned char* Vt = F.lds + 2 * TILE_B; LAS unsigned char* Rt = F.lds + 3 * TILE_B;
    constexpr int NU = NB * NCH * 4;
    TileRegs rq, rk, rv, rr;
    int unit = F.wg;
    if (unit < NU) { const size_t t0 = (size_t)(unit >> 2) * 128; const int h = unit & 3;
        tile_load(rq, U + t0 * INW + U_RQ + h * 128, INW, F.tid); tile_load(rk, U + t0 * INW + U_RK + h * 128, INW, F.tid); tile_load(rv, U + t0 * INW + U_RV + h * 128, INW, F.tid); tile_load(rr, ST + (size_t)unit * 16384, 128, F.tid); }
    for (; unit < NU; unit += F.G) {
    const int h = unit & 3, bn = unit >> 2;
    const size_t t0 = (size_t)bn * 128;
    const float lgh = __logf(1.0f - exp2f(-5.0f - (float)h));
    tile_store<2>(Qt, rq, F.tid, lgh); tile_store<3>(Kt, rk, F.tid, lgh); tile_store<0>(Vt, rv, F.tid, 0.f); tile_store<0>(Rt, rr, F.tid, 0.f);
    __syncthreads();
    const int lane = F.lane, g = lane >> 4, i = lane & 15, w = F.wave, c = 16 * w + i;
    u32x2 gwv[8];
    { const bf16* gsrc = U + (t0 + c) * INW + U_RG + h * 128 + 4 * g;
#pragma unroll
      for (int et = 0; et < 8; ++et) gwv[et] = *(const u32x2*)(gsrc + 16 * et); }
    { const int nu = unit + F.G;
      if (nu < NU) { const size_t tn = (size_t)(nu >> 2) * 128; const int hn = nu & 3;
        tile_load(rq, U + tn * INW + U_RQ + hn * 128, INW, F.tid); tile_load(rk, U + tn * INW + U_RK + hn * 128, INW, F.tid); tile_load(rv, U + tn * INW + U_RV + hn * 128, INW, F.tid); tile_load(rr, ST + (size_t)nu * 16384, 128, F.tid); } }
    bf16x8 qf[4];
#pragma unroll
    for (int s = 0; s < 4; ++s) qf[s] = row_frag(Qt, TS, c, 32 * s + 8 * g);
    f32x4 st[8];
#pragma unroll
    for (int mt = 0; mt < 8; ++mt) {
        f32x4 s = (f32x4){0.f, 0.f, 0.f, 0.f};
        if (mt <= w) {
#pragma unroll
            for (int ks = 0; ks < 4; ++ks) s = MFMA16(row_frag(Kt, TS, 16 * mt + i, 32 * ks + 8 * g), qf[ks], s);
            if (mt == w) {
#pragma unroll
                for (int r = 0; r < 4; ++r) s[r] = (i >= 4 * g + r) ? s[r] : 0.f;
            }
        }
        st[mt] = s;
    }
    f32x4 o1[8], o2[8];
#pragma unroll
    for (int et = 0; et < 8; ++et) { o1[et] = (f32x4){0.f, 0.f, 0.f, 0.f}; o2[et] = (f32x4){0.f, 0.f, 0.f, 0.f}; }
#pragma unroll
    for (int s2 = 0; s2 < 4; ++s2) {
        if (2 * s2 <= w) {
            const bf16x8 pf = pack8(st[2 * s2], st[2 * s2 + 1]);
            const int ka = 32 * s2 + 4 * g, kb = ka + 16;
#pragma unroll
            for (int et = 0; et < 8; ++et) o1[et] = MFMA16(tr_frag(Vt, TS, ka, kb, 16 * et, lane), pf, o1[et]);
        }
    }
#pragma unroll
    for (int ks = 0; ks < 4; ++ks)
#pragma unroll
        for (int et = 0; et < 8; ++et) o2[et] = MFMA16(row_frag(Rt, TS, 16 * et + i, 32 * ks + 8 * g), qf[ks], o2[et]);
    const float qd = __expf(lgh);
    float ss = 0.f;
#pragma unroll
    for (int et = 0; et < 8; ++et)
#pragma unroll
        for (int r = 0; r < 4; ++r) { const float v = o1[et][r] + qd * o2[et][r]; o1[et][r] = v; ss += v * v; }
    ss += __shfl_xor(ss, 16); ss += __shfl_xor(ss, 32);
    const float rstd = 1.0f / sqrtf(ss * (1.0f / 128.0f) + EPS);
    bf16* dst = MIX + (t0 + c) * DM + h * 128 + 4 * g;
    const float* rg = a.ret_g + h * 128 + 4 * g;
#pragma unroll
    for (int et = 0; et < 8; ++et) {
        const u32x2 gw = gwv[et]; const f32x4 gn = *(const f32x4*)(rg + 16 * et);
        const float z[4] = {bflo(gw.x), bfhi(gw.x), bflo(gw.y), bfhi(gw.y)};
        float y[4];
#pragma unroll
        for (int r = 0; r < 4; ++r) y[r] = o1[et][r] * rstd * gn[r] * (z[r] * sigmoidf_(z[r]));
        u32x2 wv; wv.x = cvt_pk(y[0], y[1]); wv.y = cvt_pk(y[2], y[3]); *(u32x2*)(dst + 16 * et) = wv;
    }
    __syncthreads();
    }
}

constexpr int P67_OFF = 96 * 1024;
static_assert(MK_N_LAUNCHES == 1, "P7 reads LDS state left by P6: the per-phase-launch debug form would need it in d_ws");
__device__ __forceinline__ void p6_router(const Args& a, const Frame& F) {
    LAS int* hist = (LAS int*)F.lds;
    LAS float* sb = (LAS float*)(F.lds + 1024);
    LAS int* le = (LAS int*)(F.lds + P67_OFF); LAS int* lrank = le + 512; LAS float* lrstd = (LAS float*)(lrank + 512);
    if (F.tid < 32) hist[F.tid] = 0;
    const float* RP = (const float*)(a.ws + WS_RP);
    float* GATE = (float*)(a.ws + WS_MISC + MS_GATE);
    const int r0 = F.wg * 128;
    {
        const float* p0 = RP + (size_t)F.wg * 8 * 528 + 4 * F.tid;
        constexpr size_t QS = (size_t)(NTOK / 16) * 528;
        f32x4 v0[4], v1[4], v2[4];
#pragma unroll
        for (int q = 0; q < 4; ++q) { v0[q] = *(const f32x4*)(p0 + q * QS); v1[q] = *(const f32x4*)(p0 + q * QS + 2048); }
        if (F.tid < 32) {
#pragma unroll
            for (int q = 0; q < 4; ++q) v2[q] = *(const f32x4*)(p0 + q * QS + 4096);
        }
        *(LAS f32x4*)(sb + 4 * F.tid) = ((v0[0] + v0[1]) + v0[2]) + v0[3]; *(LAS f32x4*)(sb + 4 * F.tid + 2048) = ((v1[0] + v1[1]) + v1[2]) + v1[3];
        if (F.tid < 32) *(LAS f32x4*)(sb + 4 * F.tid + 4096) = ((v2[0] + v2[1]) + v2[2]) + v2[3];
    }
    __syncthreads();
    const int e = F.lane & 31, half = F.lane >> 5;
    const float my_b = a.b_router[e];
    for (int it = 0; it < 8; ++it) {
        const int rl = it * 16 + F.wave * 2 + half, t = r0 + rl;
        const float raw = sb[(rl >> 4) * 528 + e * 16 + (rl & 15)], ssq = sb[(rl >> 4) * 528 + 512 + (rl & 15)];
        const float rstd = 1.0f / sqrtf(ssq * (1.0f / DM) + EPS);
        float val = raw * rstd + my_b;
        float tv[4]; int ti[4];
#pragma unroll
        for (int k = 0; k < 4; ++k) {
            float m = val;
#pragma unroll
            for (int o = 1; o < 32; o <<= 1) m = fmaxf(m, __shfl_xor(m, o));
            int idx = (val == m) ? e : 99;
#pragma unroll
            for (int o = 1; o < 32; o <<= 1) { const int x2 = __shfl_xor(idx, o); idx = x2 < idx ? x2 : idx; }
            tv[k] = m; ti[k] = idx; if (e == idx) val = -3.0e38f;
        }
        if (e < 4) {
            const int ex = e == 0 ? ti[0] : (e == 1 ? ti[1] : (e == 2 ? ti[2] : ti[3]));
            le[rl * 4 + e] = ex; lrank[rl * 4 + e] = atomicAdd((int*)(hist + ex), 1);
        }
        if (e == 0) {
            const float e1 = __expf(tv[1] - tv[0]), e2 = __expf(tv[2] - tv[0]), e3 = __expf(tv[3] - tv[0]); const float inv = 1.0f / (1.0f + e1 + e2 + e3);
            *(f32x4*)(GATE + (size_t)t * 4) = (f32x4){inv, e1 * inv, e2 * inv, e3 * inv};
            lrstd[rl] = rstd;
        }
    }
    __syncthreads();
    if (F.tid < 32) ((int*)(a.ws + WS_MISC + MS_WGCNT))[F.wg * 32 + F.tid] = hist[F.tid];
    __syncthreads();
}

__device__ __forceinline__ void p7_assign(const Args& a, const Frame& F) {
    LAS int* cnt = (LAS int*)F.lds;
    LAS int* poff = cnt + 256 * 32; LAS int* tot = poff + 40; LAS int* lbase = tot + 32; LAS int* part = lbase + 32;
    LAS int* le = (LAS int*)(F.lds + P67_OFF); LAS int* lrank = le + 512; LAS float* lrstd = (LAS float*)(lrank + 512);
    const int* WGCNT = (const int*)(a.ws + WS_MISC + MS_WGCNT);
    { int cv[16];
#pragma unroll
      for (int j = 0; j < 16; ++j) cv[j] = WGCNT[F.tid + NTHREADS * j];
#pragma unroll
      for (int j = 0; j < 16; ++j) cnt[F.tid + NTHREADS * j] = cv[j]; }
    __syncthreads();
    { const int e = F.tid & 31, pt = F.tid >> 5; int s2 = 0, b2 = 0;
#pragma unroll
      for (int j = 0; j < 16; ++j) { const int w = pt * 16 + j; const int c = cnt[w * 32 + e]; s2 += c; b2 += (w < F.wg) ? c : 0; }
      part[pt * 32 + e] = s2; part[512 + pt * 32 + e] = b2; }
    __syncthreads();
    if (F.tid < 32) {
        int c = 0, b2 = 0;
#pragma unroll
        for (int pt = 0; pt < 16; ++pt) { c += part[pt * 32 + F.tid]; b2 += part[512 + pt * 32 + F.tid]; }
        lbase[F.tid] = b2;
        const int pc = (c + 255) & ~255; int incl = pc;
#pragma unroll
        for (int o = 1; o < 32; o <<= 1) { const int y = __shfl_up(incl, o); if (F.tid >= o) incl += y; }
        tot[F.tid] = c; poff[F.tid] = incl - pc; if (F.tid == 31) poff[32] = incl;
    }
    __syncthreads();
    int* ROWTOK = (int*)(a.ws + WS_MISC + MS_ROWTOK); int* ROWSLOT = (int*)(a.ws + WS_MISC + MS_ROWSLOT); int* TILEE = (int*)(a.ws + WS_MISC + MS_TILEE); int* META = (int*)(a.ws + WS_MISC + MS_META);
    float* ROWSCALE = (float*)(a.ws + WS_MISC + MS_ROWSCALE);
    { const int slot = F.wg * 512 + F.tid, e = le[F.tid]; const int dest = poff[e] + lbase[e] + lrank[F.tid]; ROWTOK[dest] = slot >> 2; ROWSLOT[dest] = slot; ROWSCALE[dest] = lrstd[F.tid >> 2] * (1.0f / (F8_WSCALE * F8_ASCALE)); }
    if (F.wg < 32) { const int e = F.wg, p0 = poff[e], p1 = poff[e + 1];
        for (int r = p0 + tot[e] + F.tid; r < p1; r += NTHREADS) { ROWTOK[r] = NTOK; ROWSLOT[r] = -1; ROWSCALE[r] = 0.f; }
        for (int tl = (p0 >> 8) + F.tid; tl < (p1 >> 8); tl += NTHREADS) TILEE[tl] = e; }
    if (F.wg == 0 && F.tid == 0) META[0] = poff[32] >> 8;
    __syncthreads();
}

__device__ __forceinline__ void p10_combine(const Args& a, const Frame& F) {
    const unsigned char* H1F8 = a.ws + WS_H1F8; const unsigned char* Y = a.ws + WS_Y; const float* GATE = (const float*)(a.ws + WS_MISC + MS_GATE);
    unsigned char* H2F8 = a.ws + WS_H2F8;
    const int gw = F.wg * NWAVES + F.wave, NGW = F.G * NWAVES, lane = F.lane;
    for (int t0 = gw; t0 < NTOK; t0 += 2 * NGW) {
        f32x4 gtv[2]; u32x2 hqv[2][2], yv[2][2][4];
#pragma unroll
        for (int j = 0; j < 2; ++j) { const size_t t = (size_t)(t0 + j * NGW); gtv[j] = *(const f32x4*)(GATE + t * 4);
#pragma unroll
            for (int half = 0; half < 2; ++half) { const int c0 = half * 512 + 8 * lane; hqv[j][half] = *(const u32x2*)(H1F8 + t * DM + c0);
#pragma unroll
                for (int k = 0; k < 4; ++k) yv[j][half][k] = *(const u32x2*)(Y + (t * 4 + k) * DM + c0); } }
#pragma unroll
        for (int j = 0; j < 2; ++j) { const size_t t = (size_t)(t0 + j * NGW); const f32x4 gt = gtv[j];
#pragma unroll
            for (int half = 0; half < 2; ++half) {
                const int c0 = half * 512 + 8 * lane;
                const u32x2 hq = hqv[j][half];
                const f32x2 q0 = __builtin_amdgcn_cvt_pk_f32_fp8((int)hq.x, false), q1 = __builtin_amdgcn_cvt_pk_f32_fp8((int)hq.x, true), q2 = __builtin_amdgcn_cvt_pk_f32_fp8((int)hq.y, false), q3 = __builtin_amdgcn_cvt_pk_f32_fp8((int)hq.y, true);
                float v[8] = {q0[0] * (1.0f / F8_ASCALE), q0[1] * (1.0f / F8_ASCALE), q1[0] * (1.0f / F8_ASCALE), q1[1] * (1.0f / F8_ASCALE), q2[0] * (1.0f / F8_ASCALE), q2[1] * (1.0f / F8_ASCALE), q3[0] * (1.0f / F8_ASCALE), q3[1] * (1.0f / F8_ASCALE)};
#pragma unroll
                for (int k = 0; k < 4; ++k) { const u32x2 y = yv[j][half][k]; const float gk = gt[k] * (1.0f / gx::F8_YSCALE);
                    const f32x2 y0 = __builtin_amdgcn_cvt_pk_f32_fp8((int)y.x, false), y1 = __builtin_amdgcn_cvt_pk_f32_fp8((int)y.x, true), y2 = __builtin_amdgcn_cvt_pk_f32_fp8((int)y.y, false), y3 = __builtin_amdgcn_cvt_pk_f32_fp8((int)y.y, true);
                    v[0] += gk * y0[0]; v[1] += gk * y0[1]; v[2] += gk * y1[0]; v[3] += gk * y1[1]; v[4] += gk * y2[0]; v[5] += gk * y2[1]; v[6] += gk * y3[0]; v[7] += gk * y3[1]; }
                { u32x2 w8; w8.x = pk4_fp8(v[0] * F8_ASCALE, v[1] * F8_ASCALE, v[2] * F8_ASCALE, v[3] * F8_ASCALE); w8.y = pk4_fp8(v[4] * F8_ASCALE, v[5] * F8_ASCALE, v[6] * F8_ASCALE, v[7] * F8_ASCALE); *(u32x2*)(H2F8 + t * DM + c0) = w8; }
            } }
    }
}

__device__ __forceinline__ void p12_final(const Args& a, const Frame& F) {
    const unsigned char* T = a.ws + WS_MIX; const unsigned char* H2F8 = a.ws + WS_H2F8;
    const int gw = F.wg * NWAVES + F.wave, NGW = F.G * NWAVES, lane = F.lane;
    float gp[16], gf[16];
#pragma unroll
    for (int j = 0; j < 4; ++j) { const f32x4 x1 = *(const f32x4*)(a.g_ple + 256 * j + 4 * lane), x2 = *(const f32x4*)(a.g_final + 256 * j + 4 * lane);
#pragma unroll
        for (int r = 0; r < 4; ++r) { gp[j * 4 + r] = x1[r]; gf[j * 4 + r] = x2[r]; } }
    for (int t = gw; t < NTOK; t += NGW) {
        unsigned tw[4], hw[4];
#pragma unroll
        for (int j = 0; j < 4; ++j) { tw[j] = *(const unsigned*)(T + (size_t)t * DM + 256 * j + 4 * lane); hw[j] = *(const unsigned*)(H2F8 + (size_t)t * DM + 256 * j + 4 * lane); }
        float tv[16], hv[16];
#pragma unroll
        for (int j = 0; j < 4; ++j) { const f32x2 tl = __builtin_amdgcn_cvt_pk_f32_fp8((int)tw[j], false), th = __builtin_amdgcn_cvt_pk_f32_fp8((int)tw[j], true), hl = __builtin_amdgcn_cvt_pk_f32_fp8((int)hw[j], false), hh = __builtin_amdgcn_cvt_pk_f32_fp8((int)hw[j], true);
            tv[4 * j] = tl[0] * (1.0f / gx::F8_PSCALE); tv[4 * j + 1] = tl[1] * (1.0f / gx::F8_PSCALE); tv[4 * j + 2] = th[0] * (1.0f / gx::F8_PSCALE); tv[4 * j + 3] = th[1] * (1.0f / gx::F8_PSCALE);
            hv[4 * j] = hl[0] * (1.0f / F8_ASCALE); hv[4 * j + 1] = hl[1] * (1.0f / F8_ASCALE); hv[4 * j + 2] = hh[0] * (1.0f / F8_ASCALE); hv[4 * j + 3] = hh[1] * (1.0f / F8_ASCALE); }
        float s = 0.f;
#pragma unroll
        for (int i = 0; i < 16; ++i) s += tv[i] * tv[i];
        const float r1 = 1.0f / sqrtf(wave_sum(s) * (1.0f / DM) + EPS);
        float s2 = 0.f;
#pragma unroll
        for (int i = 0; i < 16; ++i) { hv[i] += tv[i] * r1 * gp[i]; s2 += hv[i] * hv[i]; }
        const float r2 = 1.0f / sqrtf(wave_sum(s2) * (1.0f / DM) + EPS);
#pragma unroll
        for (int j = 0; j < 4; ++j)
            *(f32x4*)(a.out + (size_t)t * DM + 256 * j + 4 * lane) = (f32x4){hv[4 * j] * r2 * gf[4 * j], hv[4 * j + 1] * r2 * gf[4 * j + 1], hv[4 * j + 2] * r2 * gf[4 * j + 2], hv[4 * j + 3] * r2 * gf[4 * j + 3]};
    }
}

constexpr int N_PHASES = 13;
#ifndef P1_ROUNDS_A
#define P1_ROUNDS_A 8
#endif
static_assert((NTOK / 256) * (INW / 256) == 11 * 128, "in-projection units = 11 half-grid rounds");
__global__ void __launch_bounds__(NTHREADS, 2) hymba_fwd(Args a) {
    extern __shared__ __attribute__((aligned(16))) unsigned char lds_raw[];
    Frame F;
    F.lds = (LAS unsigned char*)lds_raw;
    F.tid = threadIdx.x; F.lane = F.tid & 63; F.wave = __builtin_amdgcn_readfirstlane(F.tid >> 6);
    F.G = gridDim.x; F.wg = blockIdx.x;
    volatile LAS unsigned* MISC = (volatile LAS unsigned*)(F.lds + MISC_OFF);
    for (int u = F.tid; u < (LDS_BYTES - MISC_OFF) / 4; u += NTHREADS) ((LAS unsigned*)(F.lds + MISC_OFF))[u] = 0u;
    __syncthreads();
    unsigned* ctl = (unsigned*)(a.ws + WS_CTL);
    XcdBarrier bar; bar.bar = ctl + CW_BAR; bar.x = 0; bar.st = nullptr;
    if (MK_N_LAUNCHES == 1) bar = xcd_barrier_post(ctl + CW_BAR, MISC + 8);
    const int lo = a.ph_lo, hi = a.ph_hi;
#ifdef ONLY_PHASE
#define IN(k) ((k) == ONLY_PHASE && lo <= (k) && (k) < hi)
#else
#define IN(k) (lo <= (k) && (k) < hi)
#endif
#define SEAM(k) do { if (IN(k) && IN((k) + 1)) xcd_barrier(bar); F.tid = opaque_tid(); F.lane = F.tid & 63; F.wave = __builtin_amdgcn_readfirstlane(F.tid >> 6); } while (0)
    unsigned char* ws = a.ws;
    asm volatile("s_nop 0\n s_nop 0\n s_nop 0\n s_nop 0" ::: "memory");

    if (IN(0)) { p0_prologue(a, F); } SEAM(0);

    if (IN(1)) {
        const int half = F.G / 2; const bool grpB = F.wg >= half;
        if (grpB) p0b_experts(a, F, (F.wg - half) * NWAVES + F.wave, half * NWAVES);
        { gx::SchedDense S{NTOK / 256, INW / 256, half, grpB ? F.wg - half : F.wg, DM * 2, (const char*)(ws + WS_WIN), grpB ? P1_ROUNDS_A : 0, grpB ? 11 - P1_ROUNDS_A : P1_ROUNDS_A};
          gx::EpiU E{(bf16*)(ws + WS_U), (const float*)(ws + WS_MISC + MS_BIN), (const float*)(ws + WS_ROPE), F.lds + MOE_AUX_OFF};
          gx::gemm<false>(F.lds, (const char*)(ws + WS_XN), DM * 2, S, E); }
        {
            gx::SchedDense S{NTOK / 256, DM / 256, F.G, F.wg, PLE * 2, (const char*)(ws + WS_WP), 0, 1 << 30};
            gx::EpiF8Plain E{(unsigned char*)(ws + WS_PJ), DM};
            gx::gemm<false>(F.lds, (const char*)(ws + WS_PB), PLE * 2, S, E);
        }
    } SEAM(1);

    if (IN(2)) {
        ret_kv_phase(a, F);
        swa_phase(a, F);
    } SEAM(2);

    if (IN(3)) {
        ret_scan(a, F);
    } SEAM(3);

    if (IN(4)) { ret_out_phase(a, F); } SEAM(4);

    if (IN(5)) {
        gx::SchedDense S{NTOK / 256, DM / 256, F.G, F.wg, DM * 2, (const char*)(ws + WS_WOUT), 0, 1 << 30};
        gx::EpiRouter E{a.x, (bf16*)(ws + WS_H1B), (unsigned char*)(ws + WS_H1F8), (const bf16*)(ws + WS_MISC + MS_WRB), (float*)(ws + WS_RP), F.lds + gx::STAGE_BYTES};
        gx::gemm<false>(F.lds, (const char*)(ws + WS_MIX), DM * 2, S, E);
    } SEAM(5);

    if (IN(6)) { p6_router(a, F); } SEAM(6);
    if (IN(7)) { p7_assign(a, F); } SEAM(7);

    if (IN(8)) {
        const int ntiles = __builtin_amdgcn_readfirstlane(__hip_atomic_load((const int*)(ws + WS_MISC + MS_META), __ATOMIC_RELAXED, __HIP_MEMORY_SCOPE_AGENT));
        gx::SchedMoe<true> S{ntiles, UPW / 256, F.G, F.wg, DM, (const char*)(ws + WS_WUP), (size_t)UPW * DM, (const int*)(ws + WS_MISC + MS_TILEE), (const int*)(ws + WS_MISC + MS_ROWTOK), (LAS int*)(F.lds + gx::STAGE_BYTES)};
        S.preload(F.tid);
        gx::EpiUp E{(unsigned char*)(ws + WS_ACT), (const float*)(ws + WS_MISC + MS_BUPP), (const float*)(ws + WS_MISC + MS_ROWSCALE), F.lds + MOE_AUX_OFF};
        gx::gemm<true>(F.lds, (const char*)(ws + WS_H1F8), DM, S, E);
    } SEAM(8);

    if (IN(9)) {
        const int ntiles = __builtin_amdgcn_readfirstlane(__hip_atomic_load((const int*)(ws + WS_MISC + MS_META), __ATOMIC_RELAXED, __HIP_MEMORY_SCOPE_AGENT));
        gx::SchedMoe<false> S{ntiles, DM / 256, F.G, F.wg, DFF, (const char*)(ws + WS_WDN), (size_t)DM * DFF, (const int*)(ws + WS_MISC + MS_TILEE), nullptr, (LAS int*)(F.lds + gx::STAGE_BYTES)};
        S.preload(F.tid);
        gx::EpiDown E{(unsigned char*)(ws + WS_Y), a.b_down, (const int*)(ws + WS_MISC + MS_ROWSLOT), F.lds + MOE_AUX_OFF};
        gx::gemm<true>(F.lds, (const char*)(ws + WS_ACT), DFF, S, E);
    } SEAM(9);

    if (IN(10)) { p10_combine(a, F); } SEAM(10);

    if (IN(11)) {
        gx::SchedDenseT<true> S{NTOK / 256, DM / 256, F.G, F.wg, DM, (const char*)(ws + WS_WG), 0, 1 << 30};
        gx::EpiGate E{(const unsigned char*)(ws + WS_PJ), (unsigned char*)(ws + WS_MIX), 1.0f / (F8_WSCALE * F8_ASCALE)};
        gx::gemm<true>(F.lds, (const char*)(ws + WS_H2F8), DM, S, E);
    } SEAM(11);

    if (IN(12)) { p12_final(a, F); }
#undef IN
#undef SEAM
}

extern "C" void kernel_launch(void* const* d_in, const int* in_sizes, int n_in, void* d_out, int out_size, void* d_ws, size_t ws_size, hipStream_t stream) {
    static int ready = 0;
    if (ready == 0) {
        if (n_in != 21 || in_sizes[0] != NTOK * DM || out_size != NTOK * DM || ws_size < WS_END) { fprintf(stderr, "kernel_launch: unexpected shapes (n_in %d, ws %zu)\n", n_in, ws_size); ready = -1; return; }
        if (hipFuncSetAttribute((const void*)hymba_fwd, hipFuncAttributeMaxDynamicSharedMemorySize, LDS_BYTES) != hipSuccess) { fprintf(stderr, "kernel_launch: hipFuncSetAttribute failed\n"); ready = -1; return; }
        int per_cu = 0;
        if (hipOccupancyMaxActiveBlocksPerMultiprocessor(&per_cu, (const void*)hymba_fwd, NTHREADS, LDS_BYTES) != hipSuccess || per_cu < 1) fprintf(stderr, "kernel_launch: occupancy query says %d\n", per_cu);
        (void)hipGetLastError();
        ready = 1;
    }
    if (ready < 0) return;
    (void)hipMemsetAsync((char*)d_ws + WS_CTL, 0, CTL_ZERO_BYTES, stream);
    Args a{};
    a.x = (const float*)d_in[0]; a.p = (const float*)d_in[1]; a.positions = (const int*)d_in[2]; a.rel_bias = (const float*)d_in[3]; a.g_mix = (const float*)d_in[4];
    a.w_in = (const float*)d_in[5]; a.b_in = (const float*)d_in[6]; a.ret_g = (const float*)d_in[7]; a.sinks = (const float*)d_in[8]; a.w_out = (const float*)d_in[9];
    a.g_moe = (const float*)d_in[10]; a.w_router = (const float*)d_in[11]; a.b_router = (const float*)d_in[12]; a.w_up = (const float*)d_in[13]; a.b_up = (const float*)d_in[14];
    a.w_down = (const float*)d_in[15]; a.b_down = (const float*)d_in[16]; a.w_gate = (const float*)d_in[17]; a.w_proj = (const float*)d_in[18]; a.g_ple = (const float*)d_in[19]; a.g_final = (const float*)d_in[20];
    a.out = (float*)d_out; a.ws = (unsigned char*)d_ws;
    for (int j = 0; j < 64; ++j) a.inv[j] = (float)pow(10000.0, -(double)j / 64.0);
    for (int n = 0; n < 128; ++n) { int bkt = n; if (n >= 16) { const float v = logf((float)n / 16.0f) / (float)log(8.0) * 16.0f; bkt = 16 + (int)v; if (bkt > 31) bkt = 31; } a.bucket[n] = (unsigned char)bkt; }
#if MK_N_LAUNCHES == 1
    a.ph_lo = 0; a.ph_hi = N_PHASES;
    hipLaunchKernelGGL(hymba_fwd, dim3(GRID), dim3(NTHREADS), LDS_BYTES, stream, a);
#else
    for (int ph = 0; ph < N_PHASES; ++ph) { a.ph_lo = ph; a.ph_hi = ph + 1; hipLaunchKernelGGL(hymba_fwd, dim3(GRID), dim3(NTHREADS), LDS_BYTES, stream, a);
#ifdef REPEAT_PHASE
        if (ph == REPEAT_PHASE) for (int r = 0; r < REPEAT_N; ++r) hipLaunchKernelGGL(hymba_fwd, dim3(GRID), dim3(NTHREADS), LDS_BYTES, stream, a);
#endif
    }
#endif
}
```
